# Optimizing an MI355X kernel written in HIP

```python
import math
import jax, jax.numpy as jnp
from jax import lax
import numpy as np

D_MODEL = 1024
BATCH = 16
SEQ = 4096
DEPTH = 1

GLA_HEADS = 4
GLA_DK = 128
GLA_DV = 256
GLA_RANK = 16
GLA_GATE_NORM = 16.0
GLA_CHUNK = 64
DIFF_HEADS = 8
DIFF_DH = 64
DIFF_DV = 2 * DIFF_DH
ROT_DIM = DIFF_DH // 4
ROPE_THETA = 500000.0
Q_BLOCK = 128
D_FF = 4 * D_MODEL
EPS = 1e-6

GLA_QK = GLA_HEADS * GLA_DK
GLA_V = GLA_HEADS * GLA_DV
DIFF_QK = DIFF_HEADS * 2 * DIFF_DH
DIFF_V = DIFF_HEADS * DIFF_DV
IN_SIZES = (GLA_QK, GLA_QK, GLA_V, GLA_V, GLA_RANK, DIFF_QK, DIFF_QK, DIFF_V, 2 * D_MODEL)
D_IN = sum(IN_SIZES)
SPLIT_POINTS = [int(s) for s in np.cumsum(IN_SIZES)[:-1]]

kernel_name = "hybrid_gla_diffattn_gated_block"


def rmsnorm(x, w):
    xf = x.astype(jnp.float32)
    y = xf * lax.rsqrt(jnp.mean(xf * xf, axis=-1, keepdims=True) + EPS)
    return (y * w.astype(jnp.float32)).astype(x.dtype)


def rope_tables(positions):
    inv_freq = ROPE_THETA ** (-jnp.arange(0, ROT_DIM, 2, dtype=jnp.float32) / ROT_DIM)
    ang = positions.astype(jnp.float32)[..., None] * inv_freq
    return jnp.cos(ang)[:, :, None, None, :], jnp.sin(ang)[:, :, None, None, :]


def apply_partial_rope(t, cos, sin):
    tr, tp = t[..., :ROT_DIM], t[..., ROT_DIM:]
    t1, t2 = tr[..., :ROT_DIM // 2], tr[..., ROT_DIM // 2:]
    rot = jnp.concatenate([t1 * cos - t2 * sin, t2 * cos + t1 * sin], axis=-1).astype(t.dtype)
    return jnp.concatenate([rot, tp], axis=-1)


def gla_chunked(q, k, v, log_a):
    B, S, H, _ = q.shape
    C = GLA_CHUNK
    N = S // C

    def to_chunks(t):
        return t.astype(jnp.float32).reshape(B, N, C, H, -1).transpose(0, 3, 1, 2, 4)

    qc = to_chunks(q) * (GLA_DK ** -0.5)
    kc, vc, gc = to_chunks(k), to_chunks(v), to_chunks(log_a)
    G = jnp.cumsum(gc, axis=3)
    G_mid = G[:, :, :, C // 2:C // 2 + 1, :]
    G_last = G[:, :, :, C - 1:C, :]
    qi = qc * jnp.exp(G - G_mid)
    kj = kc * jnp.exp(G_mid - G)
    A = jnp.einsum('bhnid,bhnjd->bhnij', qi, kj)
    causal = jnp.tril(jnp.ones((C, C), dtype=bool))
    A = jnp.where(causal, A, 0.0)
    o_intra = jnp.einsum('bhnij,bhnjv->bhniv', A, vc)
    q_in = qc * jnp.exp(G)
    k_st = kc * jnp.exp(G_last - G)
    decay = jnp.exp(G_last[:, :, :, 0, :])

    def step(state, xs):
        qn, kn, vn, dn = xs
        o = jnp.einsum('bhcd,bhdv->bhcv', qn, state)
        state = dn[..., None] * state + jnp.einsum('bhcd,bhcv->bhdv', kn, vn)
        return state, o

    xs = (jnp.moveaxis(q_in, 2, 0), jnp.moveaxis(k_st, 2, 0),
          jnp.moveaxis(vc, 2, 0), jnp.moveaxis(decay, 2, 0))
    state0 = jnp.zeros((B, H, GLA_DK, GLA_DV), jnp.float32)
    _, o_inter = lax.scan(step, state0, xs)
    o = o_intra + jnp.moveaxis(o_inter, 0, 2)
    return o.transpose(0, 2, 3, 1, 4).reshape(B, S, H, GLA_DV)


def diff_attention(q, k, v, lam):
    B, S, H, _, dh = q.shape
    NB = S // Q_BLOCK
    scale = dh ** -0.5
    qb = q.reshape(B, NB, Q_BLOCK, H, 2, dh).transpose(1, 0, 3, 4, 2, 5)
    kf = k.transpose(0, 2, 3, 1, 4)
    vf = v.transpose(0, 2, 1, 3)
    kpos = jnp.arange(S)

    def block(args):
        qblk, n = args
        s = jnp.einsum('bhcqd,bhckd->bhcqk', qblk, kf).astype(jnp.float32) * scale
        qpos = n * Q_BLOCK + jnp.arange(Q_BLOCK)
        mask = kpos[None, :] <= qpos[:, None]
        s = jnp.where(mask, s, jnp.finfo(jnp.float32).min)
        p = jax.nn.softmax(s, axis=-1)
        attn = p[:, :, 0] - lam * p[:, :, 1]
        return jnp.einsum('bhqk,bhkv->bhqv', attn.astype(vf.dtype), vf)

    outs = lax.map(block, (qb, jnp.arange(NB)))
    return outs.transpose(1, 0, 3, 2, 4).reshape(B, S, H, DIFF_DV)


def setup_inputs(seed: int = 0) -> dict:
    key = jax.random.key(seed)
    ks = jax.random.split(key, 24)
    f32 = jnp.float32

    def nrm(k, shape, scale):
        return jax.random.normal(k, shape, f32) * scale

    def gain(k, n):
        return 1.0 + 0.02 * jax.random.normal(k, (DEPTH, n), f32)

    x = jax.random.normal(ks[0], (BATCH, SEQ, D_MODEL), f32)
    offsets = jax.random.randint(ks[1], (BATCH, 1), 0, 1024, dtype=jnp.int32)
    positions = offsets + jnp.arange(SEQ, dtype=jnp.int32)[None, :]
    return {
        "x": x,
        "positions": positions,
        "w_in": nrm(ks[2], (DEPTH, D_MODEL, D_IN), D_MODEL ** -0.5),
        "b_gate": nrm(ks[3], (DEPTH, 2 * D_MODEL), 0.01),
        "w_gk_up": nrm(ks[4], (DEPTH, GLA_RANK, GLA_QK), GLA_RANK ** -0.5),
        "b_gk": nrm(ks[5], (DEPTH, GLA_QK), 0.01),
        "gla_norm_w": gain(ks[6], GLA_DV),
        "lambda_q1": nrm(ks[7], (DEPTH, DIFF_DH), 0.1),
        "lambda_k1": nrm(ks[8], (DEPTH, DIFF_DH), 0.1),
        "lambda_q2": nrm(ks[9], (DEPTH, DIFF_DH), 0.1),
        "lambda_k2": nrm(ks[10], (DEPTH, DIFF_DH), 0.1),
        "diff_norm_w": gain(ks[11], DIFF_DV),
        "w_branch_a": nrm(ks[12], (DEPTH, GLA_V, D_MODEL), GLA_V ** -0.5),
        "w_branch_b": nrm(ks[13], (DEPTH, DIFF_V, D_MODEL), DIFF_V ** -0.5),
        "w_out": nrm(ks[14], (DEPTH, D_MODEL, D_MODEL), D_MODEL ** -0.5),
        "pre_mix_w": gain(ks[15], D_MODEL),
        "post_mix_w": gain(ks[16], D_MODEL),
        "pre_mlp_w": gain(ks[17], D_MODEL),
        "post_mlp_w": gain(ks[18], D_MODEL),
        "w_up": nrm(ks[19], (DEPTH, D_MODEL, D_FF), D_MODEL ** -0.5),
        "w_down": nrm(ks[20], (DEPTH, D_FF, D_MODEL), D_FF ** -0.5),
    }


def reference(x, positions, w_in, b_gate, w_gk_up, b_gk, gla_norm_w,
              lambda_q1, lambda_k1, lambda_q2, lambda_k2, diff_norm_w,
              w_branch_a, w_branch_b, w_out,
              pre_mix_w, post_mix_w, pre_mlp_w, post_mlp_w, w_up, w_down):
    B, S, _ = x.shape
    cos, sin = rope_tables(positions)
    for l in range(DEPTH):
        lam_init = 0.8 - 0.6 * math.exp(-0.3 * l)
        u = rmsnorm(x, pre_mix_w[l])
        proj = u @ w_in[l]
        (g_q, g_k, g_v, g_og, g_low, d_q, d_k, d_v, gates) = jnp.split(proj, SPLIT_POINTS, axis=-1)

        log_a = jax.nn.log_sigmoid((g_low @ w_gk_up[l] + b_gk[l]).astype(jnp.float32)) / GLA_GATE_NORM
        o_a = gla_chunked(g_q.reshape(B, S, GLA_HEADS, GLA_DK),
                          g_k.reshape(B, S, GLA_HEADS, GLA_DK),
                          g_v.reshape(B, S, GLA_HEADS, GLA_DV),
                          log_a.reshape(B, S, GLA_HEADS, GLA_DK)).astype(x.dtype)
        o_a = rmsnorm(o_a, gla_norm_w[l]) * jax.nn.silu(g_og.reshape(B, S, GLA_HEADS, GLA_DV))
        y_a = o_a.reshape(B, S, GLA_V) @ w_branch_a[l]

        dq = apply_partial_rope(d_q.reshape(B, S, DIFF_HEADS, 2, DIFF_DH), cos, sin)
        dk = apply_partial_rope(d_k.reshape(B, S, DIFF_HEADS, 2, DIFF_DH), cos, sin)
        lam = (jnp.exp(jnp.sum(lambda_q1[l].astype(jnp.float32) * lambda_k1[l].astype(jnp.float32)))
               - jnp.exp(jnp.sum(lambda_q2[l].astype(jnp.float32) * lambda_k2[l].astype(jnp.float32)))
               + lam_init)
        o_b = diff_attention(dq, dk, d_v.reshape(B, S, DIFF_HEADS, DIFF_DV), lam)
        o_b = rmsnorm(o_b, diff_norm_w[l]) * (1.0 - lam_init)
        y_b = o_b.reshape(B, S, DIFF_V) @ w_branch_b[l]

        gate_a, gate_b = jnp.split(jax.nn.sigmoid(gates + b_gate[l]), 2, axis=-1)
        mixed = (gate_a * y_a + gate_b * y_b) @ w_out[l]
        x = x + rmsnorm(mixed, post_mix_w[l])

        h = rmsnorm(x, pre_mlp_w[l])
        f = jnp.square(jax.nn.relu(h @ w_up[l])) @ w_down[l]
        x = x + rmsnorm(f, post_mlp_w[l])
    return x
```

```cpp
#include <hip/hip_runtime.h>
#include <hip/hip_cooperative_groups.h>
#include <hip/hip_bf16.h>
#include <cstdio>
#include <cstdint>
#include <cmath>
namespace cg = cooperative_groups;
namespace pg8 {
#define PG8_LAS __attribute__((address_space(3)))
typedef unsigned short bf16_t;
typedef short bf16x8 __attribute__((ext_vector_type(8)));
typedef float f32x4 __attribute__((ext_vector_type(4)));
typedef unsigned u32x4 __attribute__((ext_vector_type(4)));
constexpr int BM = 256, BK = 64, HALF = 128, HTB = HALF * BK * 2  , STAGE_BYTES = 8 * HTB, NXCD = 8, WGM = 8;

__host__ __device__ __forceinline__ int lds_byte(int r, int c) { const int st = (r >> 4) * 2 + (c >> 5), rr = r & 15, cc = c & 31, ob = rr * 64 + cc * 2; return st * 1024 + (ob ^ (((ob >> 9) & 1) << 5)); }
__host__ __device__ __forceinline__ void stage_rc(int b, int& R, int& C) { const int st = b / 1024, sb = b % 1024, swz = sb ^ (((sb >> 9) & 1) << 5); R = (st >> 1) * 16 + swz / 64; C = (st & 1) * 32 + (swz % 64) / 2; }
__host__ __device__ __forceinline__ int perm32(int rho) { const int n = rho >> 4, i = rho & 15; return 8 * (i >> 2) + 4 * n + (i & 3); }

struct Unit { int pm, pn; };
struct Gemm { const bf16_t* A; const bf16_t* Bt; int M, N, K; };

struct StaticOrder {
    int nM, nN, nwg, G, c;
    __host__ __device__ void init(int M, int N, int G_, int c_) { nM = M / BM; nN = N / BM; nwg = nM * nN; G = G_; c = c_; }
    __host__ __device__ bool next(int i, Unit& u) const {
        const long L = (long)i * G + c; if (L >= nwg) return false;
        int wgid = (int)L; { const int q = nwg / NXCD, r = nwg % NXCD, xcd = wgid % NXCD, off = wgid / NXCD; wgid = (xcd < r ? xcd * (q + 1) : r * (q + 1) + (xcd - r) * q) + off; }
        const int nig = WGM * nN, gid = wgid / nig, fm = gid * WGM, gsz = (nM - fm) < WGM ? (nM - fm) : WGM;
        u.pm = fm + ((wgid % nig) % gsz); u.pn = (wgid % nig) / gsz; return true;
    }
    __device__ __forceinline__ void a_ready(const Unit&) const {}
    __device__ __forceinline__ void done(const Unit&) const {}
};

__device__ __forceinline__ unsigned cvt_pk_bf16(float lo, float hi) { unsigned r; asm volatile("v_cvt_pk_bf16_f32 %0, %1, %2" : "=v"(r) : "v"(lo), "v"(hi)); return r; }
typedef float f32x2 __attribute__((ext_vector_type(2)));

__device__ __forceinline__ float sigmoidf_(float v) { return __builtin_amdgcn_rcpf(1.0f + __expf(-v)); }
__device__ __forceinline__ float bf_lo(unsigned w) { return __uint_as_float(w << 16); }
__device__ __forceinline__ float bf_hi(unsigned w) { return __uint_as_float(w & 0xffff0000u); }
__device__ __forceinline__ u32x4 pack8(const f32x4 a, const f32x4 b) { u32x4 w; w.x = cvt_pk_bf16(a[0], a[1]); w.y = cvt_pk_bf16(a[2], a[3]); w.z = cvt_pk_bf16(b[0], b[1]); w.w = cvt_pk_bf16(b[2], b[3]); return w; }

struct EpiP1 {
    static constexpr bool PERM = true, AFTER_DRAIN = false;
    bf16_t *GQ, *GK, *GV, *SOG, *DQ, *DK, *DV, *GATES; float* GLOW; const float* ROPE; const float* b_gate; float qscale;
    __device__ __forceinline__ void operator()(const f32x4 (&acc)[2][2][4][2], const Unit& u, int wr, int wc, int fr, int fq) const {
        const int pn = u.pn; const int row0 = u.pm * BM + wr * 64 + fr; const int cl = wc * 32 + 8 * fq;
        if (pn == 32) {
            if (wc == 0 && fq < 2) {
#pragma unroll
                for (int ai = 0; ai < 2; ++ai)
#pragma unroll
                    for (int m = 0; m < 4; ++m) { float* p = GLOW + (size_t)(row0 + ai * HALF + m * 16) * 16 + 8 * fq;
                        *(f32x4*)p = acc[ai][0][m][0]; *(f32x4*)(p + 4) = acc[ai][0][m][1]; }
            }
            return;
        }
        bf16_t* base; int ld, colt, mode = 0;
        if (pn < 2) { base = GQ; ld = 512; colt = pn * 256; }
        else if (pn < 4) { base = GK; ld = 512; colt = (pn - 2) * 256; }
        else if (pn < 8) { base = GV; ld = 1024; colt = (pn - 4) * 256; }
        else if (pn < 12) { base = SOG; ld = 1024; colt = (pn - 8) * 256; mode = 1; }
        else if (pn < 16) { base = DQ; ld = 1024; colt = (pn - 12) * 256; mode = 2; }
        else if (pn < 20) { base = DK; ld = 1024; colt = (pn - 16) * 256; mode = 2; }
        else if (pn < 24) { base = DV; ld = 1024; colt = (pn - 20) * 256; }
        else { base = GATES; ld = 2048; colt = (pn - 24) * 256; mode = 3; }
        const float sc = (pn >= 12 && pn < 16) ? qscale : 1.0f;
        if (mode == 2) {
            const bool ropew = (wc & 1) == 0;
#pragma unroll
            for (int ai = 0; ai < 2; ++ai)
#pragma unroll
                for (int m = 0; m < 4; ++m) { const int row = row0 + ai * HALF + m * 16; bf16_t* rowp = base + (size_t)row * ld + colt + cl;
                    f32x4 c0 = {1.f, 1.f, 1.f, 1.f}, c1 = c0, s0 = {0.f, 0.f, 0.f, 0.f}, s1 = s0;
                    if (ropew) { const f32x4* rp = (const f32x4*)(ROPE + (size_t)row * 16); c0 = rp[0]; c1 = rp[1]; s0 = rp[2]; s1 = rp[3]; }
#pragma unroll
                    for (int bj = 0; bj < 2; ++bj) { f32x4 v0 = acc[ai][bj][m][0], v1 = acc[ai][bj][m][1];
                        if (ropew) { f32x4 p0, p1;
#pragma unroll
                            for (int j = 0; j < 4; ++j) { p0[j] = __shfl_xor(v0[j], 16); p1[j] = __shfl_xor(v1[j], 16); }
                            if (fq == 0) { v0 = v0 * c0 - p0 * s0; v1 = v1 * c1 - p1 * s1; }
                            else if (fq == 1) { v0 = v0 * c0 + p0 * s0; v1 = v1 * c1 + p1 * s1; } }
                        v0 = v0 * sc; v1 = v1 * sc;
                        *(u32x4*)(rowp + bj * HALF) = pack8(v0, v1); } }
            return;
        }
        f32x4 bv[2][2];
#pragma unroll
        for (int bj = 0; bj < 2; ++bj)
#pragma unroll
            for (int n = 0; n < 2; ++n) bv[bj][n] = (mode == 3) ? *(const f32x4*)(b_gate + colt + cl + bj * HALF + 4 * n) : (f32x4){0.f, 0.f, 0.f, 0.f};
#pragma unroll
        for (int ai = 0; ai < 2; ++ai)
#pragma unroll
            for (int m = 0; m < 4; ++m) { bf16_t* rowp = base + (size_t)(row0 + ai * HALF + m * 16) * ld + colt + cl;
#pragma unroll
                for (int bj = 0; bj < 2; ++bj) { f32x4 v0 = acc[ai][bj][m][0] + bv[bj][0], v1 = acc[ai][bj][m][1] + bv[bj][1];
                    if (mode == 1) {
#pragma unroll
                        for (int j = 0; j < 4; ++j) { v0[j] = v0[j] * sigmoidf_(v0[j]); v1[j] = v1[j] * sigmoidf_(v1[j]); } }
                    else if (mode == 3) {
#pragma unroll
                        for (int j = 0; j < 4; ++j) { v0[j] = sigmoidf_(v0[j]); v1[j] = sigmoidf_(v1[j]); } }
                    *(u32x4*)(rowp + bj * HALF) = pack8(v0, v1); } }
    }
};

template <int MODE> struct EpiN {
    static constexpr bool PERM = true, AFTER_DRAIN = false;
    bf16_t* O; float* OF; int ldc; const bf16_t* G; int goff; const bf16_t* T;
    __device__ __forceinline__ void operator()(const f32x4 (&acc)[2][2][4][2], const Unit& u, int wr, int wc, int fr, int fq) const {
        const int row0 = u.pm * BM + wr * 64 + fr; const int col0 = u.pn * BM + wc * 32 + 8 * fq;
#pragma unroll
        for (int ai = 0; ai < 2; ++ai)
#pragma unroll
            for (int m = 0; m < 4; ++m) { const size_t row = (size_t)(row0 + ai * HALF + m * 16);
#pragma unroll
                for (int bj = 0; bj < 2; ++bj) { f32x4 v0 = acc[ai][bj][m][0], v1 = acc[ai][bj][m][1]; const int col = col0 + bj * HALF;
                    if (MODE == 0 || MODE == 1) { const u32x4 g = *(const u32x4*)(G + row * 2048 + goff + col);
                        v0 = v0 * (f32x4){bf_lo(g.x), bf_hi(g.x), bf_lo(g.y), bf_hi(g.y)}; v1 = v1 * (f32x4){bf_lo(g.z), bf_hi(g.z), bf_lo(g.w), bf_hi(g.w)}; }
                    if (MODE == 1) { const u32x4 t = *(const u32x4*)(T + row * ldc + col);
                        v0 = v0 + (f32x4){bf_lo(t.x), bf_hi(t.x), bf_lo(t.y), bf_hi(t.y)}; v1 = v1 + (f32x4){bf_lo(t.z), bf_hi(t.z), bf_lo(t.w), bf_hi(t.w)}; }
                    if (MODE == 3) {
#pragma unroll
                        for (int j = 0; j < 4; ++j) { const float a = fmaxf(v0[j], 0.f), b = fmaxf(v1[j], 0.f); v0[j] = a * a; v1[j] = b * b; } }
                    if (MODE == 2) { float* p = OF + row * ldc + col; *(f32x4*)p = v0; *(f32x4*)(p + 4) = v1; }
                    else *(u32x4*)(O + row * ldc + col) = pack8(v0, v1); } }
    }
};
template <class Epi, class Sched, bool ALIGN_EPI = false, bool SP2 = false>
__device__ __forceinline__ void gemm_phase(PG8_LAS unsigned char* lds, const Gemm g, const Sched& S, const Epi& E) {
    int tid_ = threadIdx.x; asm volatile("" : "+v"(tid_)); const int tid = tid_, wid = __builtin_amdgcn_readfirstlane(tid >> 6), lane = tid & 63, wr = wid >> 2, wc = wid & 3, fr = lane & 15, fq = lane >> 4;
    const int K = g.K, nt = K / BK;
    unsigned voffA[2], voffB[2];
#pragma unroll
    for (int i = 0; i < 2; ++i) { int R, C; stage_rc(tid * 16 + i * 8192, R, C); const int Rb = Epi::PERM ? ((R & ~31) + perm32(R & 31)) : R;
        voffA[i] = (unsigned)(R * K + C) * 2u; voffB[i] = (unsigned)(Rb * K + C) * 2u; }
    const size_t kstep = (size_t)(BK * 2);
    const size_t hstep = (size_t)HALF * K * 2;
    const size_t tstep = 2 * hstep;
    const unsigned ldsw = (unsigned)wid * 1024u;
    const int aoff = lds_byte(wr * 64 + fr, fq * 8), boff = lds_byte(wc * 32 + fr, fq * 8);
#define PG8_SA(b, h) (((b) * 2 + (h)) * HTB)
#define PG8_SB(b, h) ((4 + (b) * 2 + (h)) * HTB)
#define PG8_STAGE(bufoff, gbase, voff) do { _Pragma("unroll") for (int _i = 0; _i < 2; ++_i) \
        __builtin_amdgcn_global_load_lds((const unsigned*)((const char*)(gbase) + (voff)[_i]), (PG8_LAS unsigned*)(lds + (bufoff) + ldsw + _i * 8192), 16, 0, 0); } while (0)
#define PG8_LDA(dst, b, h) do { _Pragma("unroll") for (int m = 0; m < 4; ++m) _Pragma("unroll") for (int k = 0; k < 2; ++k) dst[m][k] = *(const PG8_LAS bf16x8*)(lds + PG8_SA(b, h) + aoff + m * 2048 + k * 1024); } while (0)
#define PG8_LDB(dst, b, h) do { _Pragma("unroll") for (int n = 0; n < 2; ++n) _Pragma("unroll") for (int k = 0; k < 2; ++k) dst[n][k] = *(const PG8_LAS bf16x8*)(lds + PG8_SB(b, h) + boff + n * 2048 + k * 1024); } while (0)
#define PG8_MMA(ai, bj, At, Bt) do { __builtin_amdgcn_s_setprio(1); _Pragma("unroll") for (int m = 0; m < 4; ++m) _Pragma("unroll") for (int n = 0; n < 2; ++n) _Pragma("unroll") for (int k = 0; k < 2; ++k) \
        acc[ai][bj][m][n] = __builtin_amdgcn_mfma_f32_16x16x32_bf16(Bt[n][k], At[m][k], acc[ai][bj][m][n], 0, 0, 0); __builtin_amdgcn_s_setprio(0); } while (0)
#define PG8_WAIT_V(n) asm volatile("s_waitcnt vmcnt(" #n ")" ::: "memory")
#define PG8_WAIT_L(n) asm volatile("s_waitcnt lgkmcnt(" #n ")" ::: "memory")
#define PG8_BAR __builtin_amdgcn_s_barrier()
#define PG8_SCHED __builtin_amdgcn_sched_barrier(0)
    Unit cur, nxt; int ui = 0;
    if (!S.next(0, cur)) return;
    f32x4 acc[2][2][4][2];
#pragma unroll
    for (int a = 0; a < 2; ++a)
#pragma unroll
        for (int b = 0; b < 2; ++b)
#pragma unroll
            for (int m = 0; m < 4; ++m)
#pragma unroll
                for (int n = 0; n < 2; ++n) acc[a][b][m][n] = (f32x4){0.f, 0.f, 0.f, 0.f};
    bf16x8 At[4][2], B0[2][2], B1[2][2];
    const char* cA = (const char*)g.A + (size_t)cur.pm * tstep; const char* cB = (const char*)g.Bt + (size_t)cur.pn * tstep;
    S.a_ready(cur);
    if constexpr (SP2) {
        PG8_STAGE(PG8_SB(0, 0), cB, voffB); PG8_STAGE(PG8_SB(0, 1), cB + hstep, voffB); PG8_STAGE(PG8_SA(0, 0), cA, voffA); PG8_STAGE(PG8_SA(0, 1), cA + hstep, voffA);
        if (wr == 1) PG8_BAR;
        PG8_WAIT_V(2); PG8_BAR;
        PG8_STAGE(PG8_SB(1, 0), cB + kstep, voffB); PG8_STAGE(PG8_SA(1, 0), cA + kstep, voffA); PG8_STAGE(PG8_SB(1, 1), cB + hstep + kstep, voffB);
        PG8_WAIT_V(6); PG8_BAR;
    } else {
        PG8_STAGE(PG8_SB(0, 0), cB, voffB); PG8_STAGE(PG8_SA(0, 0), cA, voffA); PG8_STAGE(PG8_SB(0, 1), cB + hstep, voffB); PG8_STAGE(PG8_SA(0, 1), cA + hstep, voffA);
        if (wr == 1) PG8_BAR;
        PG8_WAIT_V(4); PG8_BAR;
        PG8_STAGE(PG8_SB(1, 0), cB + kstep, voffB); PG8_STAGE(PG8_SA(1, 0), cA + kstep, voffA); PG8_STAGE(PG8_SB(1, 1), cB + hstep + kstep, voffB);
        PG8_WAIT_V(6); PG8_BAR;
    }
    for (;;) {
        const bool has_next = S.next(ui + 1, nxt);
        const char* nA = has_next ? (const char*)g.A + (size_t)nxt.pm * tstep : cA; const char* nB = has_next ? (const char*)g.Bt + (size_t)nxt.pn * tstep : cB;
        for (int t = 0; t < nt; t += 2) {
            const bool last = (t == nt - 2);
            const char* a1 = cA + (size_t)(t + 1) * kstep;
            const char* a2 = last ? nA : cA + (size_t)(t + 2) * kstep; const char* b2 = last ? nB : cB + (size_t)(t + 2) * kstep;
            const char* a3 = a2 + kstep; const char* b3 = b2 + kstep;
            if (last && has_next) S.a_ready(nxt);
            if constexpr (SP2) {
            PG8_LDB(B0, 0, 0); PG8_LDB(B1, 0, 1); PG8_SCHED; PG8_LDA(At, 0, 0); PG8_STAGE(PG8_SA(1, 1), a1 + hstep, voffA);
            PG8_WAIT_V(8); PG8_WAIT_L(0); PG8_BAR; PG8_MMA(0, 0, At, B0); PG8_MMA(0, 1, At, B1); PG8_BAR; PG8_SCHED;
            PG8_LDA(At, 0, 1); PG8_STAGE(PG8_SB(0, 0), b2, voffB); PG8_STAGE(PG8_SB(0, 1), b2 + hstep, voffB); PG8_STAGE(PG8_SA(0, 0), a2, voffA);
            PG8_WAIT_V(8); PG8_WAIT_L(0); PG8_BAR; PG8_MMA(1, 0, At, B0); PG8_MMA(1, 1, At, B1); PG8_BAR; PG8_SCHED;
            PG8_LDB(B0, 1, 0); PG8_LDB(B1, 1, 1); PG8_SCHED; PG8_LDA(At, 1, 0); PG8_STAGE(PG8_SA(0, 1), a2 + hstep, voffA);
            PG8_WAIT_V(8); PG8_WAIT_L(0); PG8_BAR; PG8_MMA(0, 0, At, B0); PG8_MMA(0, 1, At, B1); PG8_BAR; PG8_SCHED;
            PG8_LDA(At, 1, 1); PG8_STAGE(PG8_SB(1, 0), b3, voffB); PG8_STAGE(PG8_SB(1, 1), b3 + hstep, voffB); PG8_STAGE(PG8_SA(1, 0), a3, voffA);
            PG8_WAIT_V(8); PG8_WAIT_L(0); PG8_BAR; PG8_MMA(1, 0, At, B0); PG8_MMA(1, 1, At, B1); PG8_BAR; PG8_SCHED;
            } else {
            PG8_LDB(B0, 0, 0); PG8_SCHED; PG8_LDA(At, 0, 0); PG8_STAGE(PG8_SA(1, 1), a1 + hstep, voffA);
            PG8_WAIT_L(8); PG8_BAR; PG8_WAIT_L(0); PG8_MMA(0, 0, At, B0); PG8_BAR; PG8_SCHED;
            PG8_LDB(B1, 0, 1); PG8_STAGE(PG8_SB(0, 0), b2, voffB);
            PG8_BAR; PG8_WAIT_L(0); PG8_MMA(0, 1, At, B1); PG8_BAR;
            PG8_LDA(At, 0, 1); PG8_STAGE(PG8_SA(0, 0), a2, voffA);
            PG8_BAR; PG8_WAIT_L(0); PG8_MMA(1, 0, At, B0); PG8_BAR; PG8_SCHED;
            PG8_STAGE(PG8_SB(0, 1), b2 + hstep, voffB);
            PG8_WAIT_V(6); PG8_BAR; PG8_MMA(1, 1, At, B1); PG8_BAR;
            PG8_LDB(B0, 1, 0); PG8_SCHED; PG8_LDA(At, 1, 0); PG8_STAGE(PG8_SA(0, 1), a2 + hstep, voffA);
            PG8_WAIT_L(8); PG8_BAR; PG8_WAIT_L(0); PG8_MMA(0, 0, At, B0); PG8_BAR; PG8_SCHED;
            PG8_LDB(B1, 1, 1); PG8_STAGE(PG8_SB(1, 0), b3, voffB);
            PG8_BAR; PG8_WAIT_L(0); PG8_MMA(0, 1, At, B1); PG8_BAR;
            PG8_LDA(At, 1, 1); PG8_STAGE(PG8_SA(1, 0), a3, voffA);
            PG8_BAR; PG8_WAIT_L(0); PG8_MMA(1, 0, At, B0); PG8_BAR; PG8_SCHED;
            PG8_STAGE(PG8_SB(1, 1), b3 + hstep, voffB);
            PG8_WAIT_V(6); PG8_BAR; PG8_MMA(1, 1, At, B1); PG8_BAR;
            }
        }
        if constexpr (ALIGN_EPI) { if (wr == 0) PG8_BAR; }
        if constexpr (!Epi::AFTER_DRAIN) { E(acc, cur, wr, wc, fr, fq); S.done(cur); }
        if (!has_next) break;
#pragma unroll
        for (int a = 0; a < 2; ++a)
#pragma unroll
            for (int b = 0; b < 2; ++b)
#pragma unroll
                for (int m = 0; m < 4; ++m)
#pragma unroll
                    for (int n = 0; n < 2; ++n) acc[a][b][m][n] = (f32x4){0.f, 0.f, 0.f, 0.f};
        cur = nxt; cA = nA; cB = nB; ++ui;
        if constexpr (ALIGN_EPI) { if (wr == 1) PG8_BAR; }
    }
    PG8_WAIT_V(0);
    if constexpr (!ALIGN_EPI) { if (wr == 0) PG8_BAR; }
    PG8_BAR;
    if constexpr (Epi::AFTER_DRAIN) { E.fused(acc, cur, wr, wc, fr, fq, lds, wid, lane); S.done(cur); }
#undef PG8_SA
#undef PG8_SB
#undef PG8_STAGE
#undef PG8_LDA
#undef PG8_LDB
#undef PG8_MMA
#undef PG8_WAIT_V
#undef PG8_WAIT_L
#undef PG8_BAR
#undef PG8_SCHED
}
}

#ifndef PG8_SP2
#define PG8_SP2 true
#endif
#ifndef PG8_ALIGN
#define PG8_ALIGN true
#endif
namespace attn_body {
using bf16=__hip_bfloat16;
using bf16x8=__attribute__((ext_vector_type(8)))short;
using s16x4=__attribute__((ext_vector_type(4)))short;
using f32x16=__attribute__((ext_vector_type(16)))float;
using u32x4=__attribute__((ext_vector_type(4)))unsigned;
constexpr int BATCH=16,NHEAD=16,SEQ=4096,D=64,DM=NHEAD*D;
constexpr int NW=8,QBLK=32,QB=QBLK*NW,KVBLK=64,NQB=SEQ/QB;
constexpr int ATTN_PITCH=DM, ATTN_UNIT_ROWS=QB;
__device__ __forceinline__ int crow(int r,int hi){return (r&3)+8*(r>>2)+4*hi;}
#define SBAR() __builtin_amdgcn_sched_barrier(0)
__device__ __forceinline__ void cmask(f32x16&p0,f32x16&p1,int jb,int qrel,int hi){
  const float NEG=-INFINITY; int kb=64*jb+4*hi;
  #pragma unroll
  for(int r=0;r<16;++r){int kv=kb+(r&3)+8*(r>>2); if(kv>qrel)p0[r]=NEG; if(kv+32>qrel)p1[r]=NEG;}
}

constexpr int NSLOT=3, SLOTB=8192;
constexpr int LDS_K=0, LDS_V=NSLOT*SLOTB, LDS_WS=2*NSLOT*SLOTB, LDS_OST=LDS_WS+NW*64*4, LDS_STASH=LDS_OST+NW*4096, LDS_BYTES=LDS_STASH+NW*8192;
constexpr float C2=0.125f*1.4426950408889634f;
__device__ __forceinline__ void glds16(const void*gsrc,unsigned lds_dst){unsigned keep;
  asm volatile("s_mov_b32 %0, m0\n\ts_mov_b32 m0, %2\n\ts_nop 0\n\tglobal_load_lds_dwordx4 %1, off\n\ts_mov_b32 m0, %0":"=&s"(keep):"v"(gsrc),"s"(lds_dst):"memory");}
__device__ __forceinline__ float max3f(float a,float b,float c){float r;asm("v_max3_f32 %0, %1, %2, %3":"=v"(r):"v"(a),"v"(b),"v"(c));return r;}
__device__ __forceinline__ float max2f(float a,float b){float r;asm("v_max_f32_e32 %0, %1, %2":"=v"(r):"v"(a),"v"(b));return r;}
__device__ __forceinline__ float fadd_s(float a,float b){float r;asm("v_add_f32_e32 %0, %1, %2":"=v"(r):"v"(a),"v"(b));return r;}
__device__ __forceinline__ float fsub_s(float a,float b){float r;asm("v_sub_f32_e32 %0, %1, %2":"=v"(r):"v"(a),"v"(b));return r;}
typedef float f32x2_t __attribute__((ext_vector_type(2))); typedef __bf16 bf16x2_t __attribute__((ext_vector_type(2)));
__device__ __forceinline__ unsigned cvtpk_s(float lo,float hi){f32x2_t v={lo,hi};bf16x2_t b=__builtin_convertvector(v,bf16x2_t);return __builtin_bit_cast(unsigned,b);}
#define WAIT_BAR(N) asm volatile("s_waitcnt vmcnt(" #N ") lgkmcnt(0)\n\ts_barrier":::"memory")

__device__ __forceinline__ void qkt(f32x16&p0,f32x16&p1,const char*Kslot,const bf16x8*qr,const f32x16&negm,int r32,int hi){
  const char*kb=Kslot+hi*1024+r32*16;
  #pragma unroll
  for(int d0=0;d0<4;++d0){
    const bf16x8 b0=*reinterpret_cast<const bf16x8*>(kb+d0*2048);
    const bf16x8 b1=*reinterpret_cast<const bf16x8*>(kb+d0*2048+512);
    if(d0==0){p0=__builtin_amdgcn_mfma_f32_32x32x16_bf16(b0,qr[0],negm,0,0,0);p1=__builtin_amdgcn_mfma_f32_32x32x16_bf16(b1,qr[0],negm,0,0,0);}
    else{p0=__builtin_amdgcn_mfma_f32_32x32x16_bf16(b0,qr[d0],p0,0,0,0);p1=__builtin_amdgcn_mfma_f32_32x32x16_bf16(b1,qr[d0],p1,0,0,0);}}
}
typedef __attribute__((address_space(3))) const char* lds_cptr;
typedef short v4i16_t __attribute__((ext_vector_type(4)));
__device__ __forceinline__ void kload8(bf16x8*kf,lds_cptr kp){
  kf[0]=*(const __attribute__((address_space(3))) bf16x8*)(kp);      kf[1]=*(const __attribute__((address_space(3))) bf16x8*)(kp+512);
  kf[2]=*(const __attribute__((address_space(3))) bf16x8*)(kp+2048); kf[3]=*(const __attribute__((address_space(3))) bf16x8*)(kp+2560);
  kf[4]=*(const __attribute__((address_space(3))) bf16x8*)(kp+4096); kf[5]=*(const __attribute__((address_space(3))) bf16x8*)(kp+4608);
  kf[6]=*(const __attribute__((address_space(3))) bf16x8*)(kp+6144); kf[7]=*(const __attribute__((address_space(3))) bf16x8*)(kp+6656);
}
__device__ __forceinline__ void kload2(bf16x8*kf,lds_cptr kp,int j){ kf[2*j]=*(const __attribute__((address_space(3))) bf16x8*)(kp+j*2048); kf[2*j+1]=*(const __attribute__((address_space(3))) bf16x8*)(kp+j*2048+512); }
__device__ __forceinline__ s16x4 vtr(lds_cptr p){ return __builtin_bit_cast(s16x4,__builtin_amdgcn_ds_read_tr16_b64_v4i16((__attribute__((address_space(3))) v4i16_t*)p)); }
__device__ __forceinline__ float rowmax(const f32x16&p0,const f32x16&p1){
  float a=max3f(p0[0],p0[1],p1[0]),b=max3f(p0[2],p0[3],p1[1]);a=max3f(a,p1[2],p1[3]);
  #pragma unroll
  for(int r=4;r<16;r+=4){a=max3f(a,p0[r],p0[r+1]);b=max3f(b,p0[r+2],p0[r+3]);a=max3f(a,p1[r],p1[r+1]);b=max3f(b,p1[r+2],p1[r+3]);}
  const float m=max2f(a,b);
  auto rr=__builtin_amdgcn_permlane32_swap(__float_as_uint(m),__float_as_uint(m),false,false);
  return max2f(__uint_as_float(rr[0]),__uint_as_float(rr[1]));
}
__device__ __forceinline__ void pv(f32x16*o,int vb,bf16x8 pa0,bf16x8 pa1,bf16x8 pa2,bf16x8 pa3){
  #pragma unroll
  for(int d0=0;d0<2;++d0){s16x4 lo[4],hi[4];
    #pragma unroll
    for(int ks=0;ks<4;++ks){
      asm volatile("ds_read_b64_tr_b16 %0,%1 offset:%c2":"=&v"(lo[ks]):"v"(vb),"i"(d0*4096+ks*1024):"memory");
      asm volatile("ds_read_b64_tr_b16 %0,%1 offset:%c2":"=&v"(hi[ks]):"v"(vb),"i"(d0*4096+ks*1024+512):"memory");}
    asm volatile("s_waitcnt lgkmcnt(0)":::"memory");SBAR();
    #define PK(k) (bf16x8){lo[k][0],lo[k][1],lo[k][2],lo[k][3],hi[k][0],hi[k][1],hi[k][2],hi[k][3]}
    o[d0]=__builtin_amdgcn_mfma_f32_32x32x16_bf16(pa0,PK(0),o[d0],0,0,0);
    o[d0]=__builtin_amdgcn_mfma_f32_32x32x16_bf16(pa1,PK(1),o[d0],0,0,0);
    o[d0]=__builtin_amdgcn_mfma_f32_32x32x16_bf16(pa2,PK(2),o[d0],0,0,0);
    o[d0]=__builtin_amdgcn_mfma_f32_32x32x16_bf16(pa3,PK(3),o[d0],0,0,0);
    #undef PK
  }
}

#ifndef ATTN_STORE16
#define ATTN_STORE16(p,v) (*(u32x4*)(p)=(v))
#endif
template<int THRL> __device__ __forceinline__ void attn_unit(int b,int h,int hv,int qb,const bf16*Q,const bf16*__restrict__ K,const bf16*__restrict__ V,bf16*O,char*shm,int mode,float lam){
  int tid_=threadIdx.x; asm volatile("":"+v"(tid_)); const int tid=tid_,lane=tid&63,r32=lane&31,hi=lane>>5; const int wid=__builtin_amdgcn_readfirstlane(tid>>6);
  const long rowbase=(long)b*SEQ; const int q0=qb*QB;
  const bf16*Qw=Q+(rowbase+q0+wid*QBLK)*DM+h*D;
  const bf16*Kh=K+rowbase*DM+h*D,*Vh=V+rowbase*DM+hv*D;
  const unsigned lds0=(unsigned)(uintptr_t)shm;
  float*wsf=(float*)(shm+LDS_WS)+wid*64;
  const bf16*ksrc=Kh+(long)lane*DM+wid*8;
  const bf16*vsrc=Vh+(long)(16*(wid&3)+(lane>>2))*DM+(wid>>2)*32+(lane&3)*8;
  const unsigned kdst=lds0+LDS_K+wid*1024, vdst=lds0+LDS_V+wid*1024;
  #define DMA_K(t,slot) glds16(ksrc+(long)(t)*KVBLK*DM,(unsigned)__builtin_amdgcn_readfirstlane(kdst+(slot)))
  #define DMA_V(t,slot) glds16(vsrc+(long)(t)*KVBLK*DM,(unsigned)__builtin_amdgcn_readfirstlane(vdst+(slot)))
  const int vb0=(int)(lds0+LDS_V)+((lane>>4)&1)*32+(lane&3)*8+(4*hi+((lane&15)>>2))*64;
  const char*Kbase=shm+LDS_K; bf16x8 kf[8];
  const lds_cptr shm3=(lds_cptr)shm; const lds_cptr kp0=shm3+LDS_K+hi*1024+r32*16; const lds_cptr vp0=shm3+LDS_V+((lane>>4)&1)*32+(lane&3)*8+(4*hi+((lane&15)>>2))*64;
  const int NT=(q0+QB)/KVBLK;
  DMA_K(0,0);DMA_V(0,0);DMA_K(1,SLOTB);
  bf16x8 qr[4];
  #pragma unroll
  for(int d0=0;d0<4;++d0)qr[d0]=*reinterpret_cast<const bf16x8*>(&Qw[(long)r32*DM+d0*16+hi*8]);
  float mhat=0.f,l_reg=0.f;f32x16 o[2];o[0]=f32x16{};o[1]=f32x16{};f32x16 negm=f32x16{};asm volatile("":"+v"(negm));
  const int qrel=wid*QBLK+r32;
  #define CMASK(P0,P1,t) do{int jb_=(t)-(NT-4); if(jb_>=0)cmask(P0,P1,jb_,qrel,hi);}while(0)
  bool resc=false;
  #define START(P0,P1) do{ const float rm=rowmax(P0,P1); resc=false; \
    { const float dl=rm; mhat=fadd_s(mhat,dl); \
      _Pragma("unroll") for(int r=0;r<16;++r){P0[r]=fsub_s(P0[r],dl);P1[r]=fsub_s(P1[r],dl);} \
      _Pragma("unroll") for(int r=0;r<16;++r)negm[r]=-mhat; asm volatile("":"+v"(negm)); } \
    _Pragma("unroll") for(int r=0;r<16;++r)P0[r]=__builtin_amdgcn_exp2f(P0[r]); }while(0)
  #define RESC() do{ if(resc){ asm volatile("s_waitcnt lgkmcnt(0)":::"memory"); \
      _Pragma("unroll") for(int d_=0;d_<2;++d_) _Pragma("unroll") for(int r=0;r<16;++r)o[d_][r]*=wsf[crow(r,hi)]; } }while(0)
  f32x16 pA0,pA1,pB0,pB1;
  int sl_prev=0,sl_cur=0,sl_next=SLOTB;
  #define ROT() do{sl_prev=sl_cur;sl_cur=sl_next;sl_next=(sl_next==(NSLOT-1)*SLOTB)?0:sl_next+SLOTB;}while(0)
  DMA_K(2,2*SLOTB);
  WAIT_BAR(3);
  qkt(pA0,pA1,Kbase,qr,negm,r32,hi);asm volatile("s_nop 15\n\ts_nop 7":"+v"(pA0),"+v"(pA1));CMASK(pA0,pA1,0);
  START(pA0,pA1);
  _Pragma("unroll") for(int r=0;r<16;++r)pA1[r]=__builtin_amdgcn_exp2f(pA1[r]);
  WAIT_BAR(0);
  DMA_K(3,0);DMA_V(1,SLOTB);
  ROT();
  kload8(kf,kp0+sl_cur);
  WAIT_BAR(2);
  s16x4 vlo[8],vhi[8]; u32x4 pw0,pw1,pw2,pw3;
  #define PKW(P,B) cvtpk_s(P[B],P[B+1])
  #define PAF(k) __builtin_bit_cast(bf16x8,pw##k)
  #define VFR(i) (bf16x8){vlo[i][0],vlo[i][1],vlo[i][2],vlo[i][3],vhi[i][0],vhi[i][1],vhi[i][2],vhi[i][3]}
  #define PIN(x) asm volatile("":"+v"(x))
  #define MX3(a,b,c) __builtin_fmaxf(__builtin_fmaxf((a),(b)),(c))
  #define GAPA(MF,A0,A1,A2,A3,W0,W1,PW) do{ MF; sacc+=A0; sacc+=A1; sacc+=A2; sacc+=A3; PIN(sacc); W0; W1; PIN(PW); SBAR(); }while(0)
  #define EX(v) __builtin_amdgcn_exp2f(v)
  #define GAPB(MF,X,B) do{ MF; X[B]=EX(X[B]); X[B+1]=EX(X[B+1]); X[B+2]=EX(X[B+2]); X[B+3]=EX(X[B+3]); PIN(X); SBAR(); }while(0)
  #define VRD(i) do{ vlo[i]=vtr(vp_+(((i)>>2)*4096+((i)&3)*1024)); vhi[i]=vtr(vp_+(((i)>>2)*4096+((i)&3)*1024+512)); }while(0)
  #define KRD(G,j) do{ if(G){ kload2(kf,kp0+sl_next,j); SBAR(); } }while(0)
  #define STEP(C0,C1,P0,P1,t,GK,GV,GL) do{ SBAR(); \
    const lds_cptr vp_=vp0+sl_prev; \
    VRD(0); SBAR(); float sacc=(P0[0]+P0[1]); \
    GAPA(C0=__builtin_amdgcn_mfma_f32_32x32x16_bf16(kf[0],qr[0],negm,0,0,0), P0[2],P0[3],P0[4],P0[5],     pw0[0]=PKW(P0,0), pw0[1]=PKW(P0,2), pw0); \
    VRD(4); SBAR(); GAPA(C1=__builtin_amdgcn_mfma_f32_32x32x16_bf16(kf[1],qr[0],negm,0,0,0), P0[6],P0[7],P0[8],P0[9],     pw0[2]=PKW(P0,4), pw0[3]=PKW(P0,6), pw0); \
    VRD(1); SBAR(); GAPA(C0=__builtin_amdgcn_mfma_f32_32x32x16_bf16(kf[2],qr[1],C0,0,0,0),   P0[10],P0[11],P0[12],P0[13], pw1[0]=PKW(P0,8), pw1[1]=PKW(P0,10), pw1); \
    VRD(5); SBAR(); GAPA(C1=__builtin_amdgcn_mfma_f32_32x32x16_bf16(kf[3],qr[1],C1,0,0,0),   P0[14],P0[15],P1[0],P1[1],   pw1[2]=PKW(P0,12),pw1[3]=PKW(P0,14), pw1); \
    VRD(2); SBAR(); GAPA(C0=__builtin_amdgcn_mfma_f32_32x32x16_bf16(kf[4],qr[2],C0,0,0,0),   P1[2],P1[3],P1[4],P1[5],     pw2[0]=PKW(P1,0), pw2[1]=PKW(P1,2), pw2); \
    VRD(6); SBAR(); GAPA(C1=__builtin_amdgcn_mfma_f32_32x32x16_bf16(kf[5],qr[2],C1,0,0,0),   P1[6],P1[7],P1[8],P1[9],     pw2[2]=PKW(P1,4), pw2[3]=PKW(P1,6), pw2); \
    VRD(3); SBAR(); GAPA(C0=__builtin_amdgcn_mfma_f32_32x32x16_bf16(kf[6],qr[3],C0,0,0,0),   P1[10],P1[11],P1[12],P1[13], pw3[0]=PKW(P1,8), pw3[1]=PKW(P1,10), pw3); \
    VRD(7); SBAR(); GAPA(C1=__builtin_amdgcn_mfma_f32_32x32x16_bf16(kf[7],qr[3],C1,0,0,0),   P1[14],P1[15],0.f,0.f,       pw3[2]=PKW(P1,12),pw3[3]=PKW(P1,14), pw3); \
    l_reg+=sacc; \
    if(GK){DMA_K((t)+3,sl_cur);} if(GV){DMA_V((t)+1,sl_next);} \
    CMASK(C0,C1,t); \
    { float a=MX3(C0[0],C0[1],C1[0]),b=MX3(C0[2],C0[3],C1[1]); a=MX3(a,C1[2],C1[3]); \
      _Pragma("unroll") for(int r=4;r<16;r+=4){a=MX3(a,C0[r],C0[r+1]);b=MX3(b,C0[r+2],C0[r+3]);a=MX3(a,C1[r],C1[r+1]);b=MX3(b,C1[r+2],C1[r+3]);} \
      float rm=__builtin_fmaxf(a,b); { auto rr=__builtin_amdgcn_permlane32_swap(__float_as_uint(rm),__float_as_uint(rm),false,false); rm=__builtin_fmaxf(__uint_as_float(rr[0]),__uint_as_float(rr[1])); } \
      resc=false; \
      if(__builtin_expect(__any(rm>(float)THRL),0)){ const float dl=__builtin_fmaxf(rm,0.f); mhat+=dl; \
        _Pragma("unroll") for(int r=0;r<16;++r){C0[r]-=dl;C1[r]-=dl;} \
        _Pragma("unroll") for(int r=0;r<16;++r)negm[r]=-mhat; asm volatile("":"+v"(negm)); \
        const float f=__builtin_amdgcn_exp2f(-dl); l_reg*=f; if(hi==0)wsf[r32]=f; resc=true; } } \
    SBAR(); \
    GAPB(o[0]=__builtin_amdgcn_mfma_f32_32x32x16_bf16(PAF(0),VFR(0),o[0],0,0,0), C0,0); \
    GAPB(o[1]=__builtin_amdgcn_mfma_f32_32x32x16_bf16(PAF(0),VFR(4),o[1],0,0,0), C0,4); \
    KRD(GL,0); GAPB(o[0]=__builtin_amdgcn_mfma_f32_32x32x16_bf16(PAF(1),VFR(1),o[0],0,0,0), C0,8); \
    KRD(GL,1); GAPB(o[1]=__builtin_amdgcn_mfma_f32_32x32x16_bf16(PAF(1),VFR(5),o[1],0,0,0), C0,12); \
    KRD(GL,2); GAPB(o[0]=__builtin_amdgcn_mfma_f32_32x32x16_bf16(PAF(2),VFR(2),o[0],0,0,0), C1,0); \
    KRD(GL,3); GAPB(o[1]=__builtin_amdgcn_mfma_f32_32x32x16_bf16(PAF(2),VFR(6),o[1],0,0,0), C1,4); \
    GAPB(o[0]=__builtin_amdgcn_mfma_f32_32x32x16_bf16(PAF(3),VFR(3),o[0],0,0,0), C1,8); \
    GAPB(o[1]=__builtin_amdgcn_mfma_f32_32x32x16_bf16(PAF(3),VFR(7),o[1],0,0,0), C1,12); \
    }while(0)
  int t=1;
  #undef CMASK
  #define CMASK(P0,P1,t) do{}while(0)
  for(;t+5<NT;t+=2){
    STEP(pB0,pB1,pA0,pA1,t,true,true,true);     WAIT_BAR(2); RESC(); ROT();
    STEP(pA0,pA1,pB0,pB1,t+1,true,true,true);   WAIT_BAR(2); RESC(); ROT();
  }
  #undef CMASK
  #define CMASK(P0,P1,t) do{int jb_=(t)-(NT-4); if(jb_>=0)cmask(P0,P1,jb_,qrel,hi);}while(0)
  #define ENDW(tt) do{ if((tt)+3<NT){WAIT_BAR(2);} else if((tt)+2<NT){WAIT_BAR(1);} else {WAIT_BAR(0);} }while(0)
  for(;t+1<NT;t+=2){
    STEP(pB0,pB1,pA0,pA1,t,(t+3<NT),(t+1<NT),(t+1<NT));       ENDW(t);   RESC(); ROT();
    STEP(pA0,pA1,pB0,pB1,t+1,(t+4<NT),(t+2<NT),(t+2<NT));     ENDW(t+1); RESC(); ROT();
  }
  STEP(pB0,pB1,pA0,pA1,NT-1,false,false,false); RESC();
  { float sacc=pB0[0]+pB0[1]; _Pragma("unroll") for(int r=2;r<16;++r)sacc+=pB0[r]; _Pragma("unroll") for(int r=0;r<16;++r)sacc+=pB1[r]; l_reg+=sacc;
    pw0=(u32x4){PKW(pB0,0),PKW(pB0,2),PKW(pB0,4),PKW(pB0,6)};pw1=(u32x4){PKW(pB0,8),PKW(pB0,10),PKW(pB0,12),PKW(pB0,14)};pw2=(u32x4){PKW(pB1,0),PKW(pB1,2),PKW(pB1,4),PKW(pB1,6)};pw3=(u32x4){PKW(pB1,8),PKW(pB1,10),PKW(pB1,12),PKW(pB1,14)};
    SBAR(); pv(o,vb0+sl_cur,PAF(0),PAF(1),PAF(2),PAF(3)); }
  #undef PKW
  #undef PAF
  #undef VFR
  #undef PIN
  #undef MX3
  #undef GAPA
  #undef GAPB
  #undef EX
  #undef VRD
  #undef KRD
  #undef STEP
  #undef ENDW
  {auto rr=__builtin_amdgcn_permlane32_swap(__float_as_uint(l_reg),__float_as_uint(l_reg),false,false);l_reg=__uint_as_float(rr[0])+__uint_as_float(rr[1]);}
  if(hi==0)wsf[32+r32]=l_reg;asm volatile("s_waitcnt lgkmcnt(0)":::"memory");
  float rli[16];
  #pragma unroll
  for(int r=0;r<16;++r)rli[r]=__builtin_amdgcn_rcpf(wsf[32+crow(r,hi)]);
  bf16*Ow=O+(rowbase+q0+wid*QBLK)*DM+hv*D;
  float*stash=(float*)(shm+LDS_STASH)+wid*2048;
  if(mode==0){
    #pragma unroll
    for(int r=0;r<16;++r){
      #pragma unroll
      for(int d0=0;d0<2;++d0)stash[(d0*16+r)*64+lane]=o[d0][r]*rli[r];}
    asm volatile("s_waitcnt lgkmcnt(0)":::"memory");
  } else { bf16*stg=(bf16*)(shm+LDS_OST)+wid*2048;
    #pragma unroll
    for(int r=0;r<16;++r){const int orow=crow(r,hi);
      #pragma unroll
      for(int d0=0;d0<2;++d0)stg[orow*64+d0*32+r32]=__float2bfloat16(stash[(d0*16+r)*64+lane]-lam*(o[d0][r]*rli[r]));}
    asm volatile("s_waitcnt lgkmcnt(0)":::"memory");
    #pragma unroll
    for(int i=0;i<4;++i){const int row=i*8+(lane>>3),ch=lane&7; const u32x4 v=*(const u32x4*)(stg+row*64+ch*8); ATTN_STORE16(Ow+(long)row*DM+ch*8,v);} }
  asm volatile("s_waitcnt lgkmcnt(0)\n\ts_barrier":::"memory");
  #undef DMA_K
  #undef DMA_V
  #undef CMASK
  #undef START
  #undef RESC
  #undef ROT
}
constexpr int ATTN_LDS_BYTES=LDS_BYTES;
struct AttnTensors { const bf16* Q; const bf16* K; const bf16* V; bf16* O; };
template<int THRL=8> __device__ __forceinline__ void attn_phase(char*lds,const AttnTensors&T,int vcu,int G,float lam){
  for(int ubase=vcu*32; ubase<BATCH*8*2*32; ubase+=G*32)
  for(int i=0;i<32;++i){ const int uu=ubase+i, s2=uu>>5, j=(uu>>1)&15, sub=uu&1; const int qb=(j&1)?(NQB-1-(j>>1)):(j>>1);
      attn_unit<THRL>(s2>>4,((s2>>1)&7)*2+sub,(s2&15),qb,T.Q,T.K,T.V,T.O,lds,sub,lam); }
}
#undef SBAR
#undef WAIT_BAR
}

#define LAS __attribute__((address_space(3)))
typedef unsigned short bf16;
typedef unsigned v4u __attribute__((ext_vector_type(4)));
typedef unsigned v2u __attribute__((ext_vector_type(2)));
typedef float f32x4 __attribute__((ext_vector_type(4)));
typedef float f32x2v __attribute__((ext_vector_type(2)));
typedef short bf16x8 __attribute__((ext_vector_type(8)));
constexpr int NWAVES = 8, NTHR = 512;
constexpr int BATCH = 16, SEQ = 4096, D = 1024, M = BATCH * SEQ, FF = 4096;
constexpr int N1 = 8448;
constexpr float EPS = 1e-6f;
constexpr size_t MiB = 1u << 20;
constexpr size_t WS_W1 = 1 * MiB, WS_WA = 18 * MiB, WS_WB = 20 * MiB, WS_WO = 22 * MiB, WS_WUP = 24 * MiB, WS_WDN = 32 * MiB;
constexpr size_t WS_ROPE = 40 * MiB, WS_GLOW = 44 * MiB;
constexpr size_t WS_U = 48 * MiB;
constexpr size_t WS_GQ = 176 * MiB, WS_GK = 240 * MiB, WS_GV = 304 * MiB, WS_SOG = 432 * MiB, WS_DQ = 560 * MiB, WS_DK = 688 * MiB, WS_DV = 816 * MiB, WS_END = 944 * MiB;
constexpr size_t WS_T = WS_DQ, WS_MIXIN = WS_DK, WS_MIXED = WS_GQ, WS_HMID = WS_SOG, WS_F = WS_GQ;
constexpr int LDS_BYTES = 155648;

__device__ __forceinline__ unsigned f2bf(float f) { unsigned u = __builtin_bit_cast(unsigned, f); return (u + 0x7fffu + ((u >> 16) & 1u)) >> 16; }
__device__ __forceinline__ unsigned pk2(float lo, float hi) { return f2bf(lo) | (f2bf(hi) << 16); }
__device__ __forceinline__ float bflo(unsigned w) { return __uint_as_float(w << 16); }
__device__ __forceinline__ float bfhi(unsigned w) { return __uint_as_float(w & 0xffff0000u); }
__device__ __forceinline__ float wave_sum(float v) {
#pragma unroll
    for (int o = 1; o < 64; o <<= 1) v += __shfl_xor(v, o);
    return v;
}

__device__ __forceinline__ int w1_src_col(int n) { return n < 3072 ? n : (n < 8192 ? n + 16 : (n < 8208 ? n - 8192 + 3072 : -1)); }
template <bool REMAP> __device__ __forceinline__ void p0_transpose_item(const float* W, int K, int N, int NT, bf16* WT, LAS float* scr, int item, int lane) {
    const int nblk = NT / 32, kb = item / nblk, nb = item % nblk, k0 = 64 * kb, n0 = 32 * nb;
    const int sc = REMAP ? w1_src_col(n0 + (lane & 31)) : n0 + (lane & 31);
#pragma unroll 8
    for (int i = 0; i < 32; ++i) { const int kk = 2 * i + (lane >> 5); scr[kk * 33 + (lane & 31)] = sc >= 0 ? W[(size_t)(k0 + kk) * N + sc] : 0.f; }
    asm volatile("s_waitcnt lgkmcnt(0)" ::: "memory");
    const int c = lane & 7;
#pragma unroll
    for (int j = 0; j < 4; ++j) { const int n = (lane >> 3) + 8 * j; const LAS float* s = scr + (8 * c) * 33 + n;
        v4u o; o.x = pk2(s[0 * 33], s[1 * 33]); o.y = pk2(s[2 * 33], s[3 * 33]); o.z = pk2(s[4 * 33], s[5 * 33]); o.w = pk2(s[6 * 33], s[7 * 33]);
        *(v4u*)(WT + (size_t)(n0 + n) * K + k0 + 8 * c) = o; }
    asm volatile("s_waitcnt lgkmcnt(0)" ::: "memory");
}

struct Args { const float* in[21]; float* out; unsigned char* ws; };

__device__ __forceinline__ void p0_prologue(const Args& a, LAS unsigned char* lds, int gw, int NGW, int wave, int lane) {
    LAS float* scr = (LAS float*)(lds + wave * 16384);
    unsigned char* ws = a.ws;
    constexpr int I_1 = (D / 64) * (N1 / 32), I_S = (D / 64) * (D / 32), I_UP = (D / 64) * (FF / 32), I_DN = (FF / 64) * (D / 32);
    constexpr int NITEMS = I_1 + 3 * I_S + I_UP + I_DN;
    for (int it = gw; it < NITEMS; it += NGW) {
        int r = it;
        if (r < I_1) { p0_transpose_item<true>(a.in[2], D, 8208, N1, (bf16*)(ws + WS_W1), scr, r, lane); continue; } r -= I_1;
        if (r < I_S) { p0_transpose_item<false>(a.in[12], D, D, D, (bf16*)(ws + WS_WA), scr, r, lane); continue; } r -= I_S;
        if (r < I_S) { p0_transpose_item<false>(a.in[13], D, D, D, (bf16*)(ws + WS_WB), scr, r, lane); continue; } r -= I_S;
        if (r < I_S) { p0_transpose_item<false>(a.in[14], D, D, D, (bf16*)(ws + WS_WO), scr, r, lane); continue; } r -= I_S;
        if (r < I_UP) { p0_transpose_item<false>(a.in[19], D, FF, FF, (bf16*)(ws + WS_WUP), scr, r, lane); continue; } r -= I_UP;
        p0_transpose_item<false>(a.in[20], FF, D, D, (bf16*)(ws + WS_WDN), scr, r, lane);
    }
    { const int* pos = (const int*)a.in[1]; float* rope = (float*)(ws + WS_ROPE);
      for (int e = gw * 64 + lane; e < M * 8; e += NGW * 64) { const int m = e >> 3, i = e & 7;
          const float inv = exp2f(-(float)i * 0.125f * 18.931568569324174f);
          const double rev = (double)pos[m] * (double)inv * 0.15915494309189535;
          const float fr = (float)(rev - rint(rev));
          rope[(size_t)m * 16 + i] = __builtin_amdgcn_cosf(fr); rope[(size_t)m * 16 + 8 + i] = __builtin_amdgcn_sinf(fr); } }
    { const float* x = a.in[0]; const float* w = a.in[15]; bf16* U = (bf16*)(ws + WS_U);
      f32x4 wv[4];
#pragma unroll
      for (int j = 0; j < 4; ++j) wv[j] = ((const f32x4*)w)[64 * j + lane];
      for (int m = gw; m < M; m += NGW) { const f32x4* xr = (const f32x4*)(x + (size_t)m * D) + lane; f32x4 v[4]; float s = 0.f;
#pragma unroll
          for (int j = 0; j < 4; ++j) { v[j] = xr[64 * j]; s += (v[j].x * v[j].x + v[j].y * v[j].y) + (v[j].z * v[j].z + v[j].w * v[j].w); }
          const float rstd = rsqrtf(wave_sum(s) * (1.f / D) + EPS);
          unsigned long long* o8 = (unsigned long long*)(U + (size_t)m * D) + lane;
#pragma unroll
          for (int j = 0; j < 4; ++j) { const f32x4 t = v[j] * rstd * wv[j]; o8[64 * j] = (unsigned long long)pk2(t.x, t.y) | ((unsigned long long)pk2(t.z, t.w) << 32); } } }
}

namespace gla {
constexpr int C = 64, DK = 128, DVS = 64, NCH = SEQ / C;
constexpr int PQ = 136, PJ = 72;
constexpr int O_QI = 0, O_KJ = O_QI + 64 * PQ * 2, O_QIN = O_KJ + 64 * PQ * 2, O_KST = O_QIN + 64 * PQ * 2, O_VT = O_KST + 128 * PJ * 2, O_AM = O_VT + 64 * PJ * 2,
              O_SB = O_AM + 64 * PJ * 2, O_GL = O_SB + 2 * 64 * PQ * 2, O_T = O_GL + 64 * 16 * 4, O_DEC = O_T + 2 * 10 * 128 * 4, O_END = O_DEC + 128 * 4;
static_assert(O_END <= LDS_BYTES, "gla LDS");
typedef float f32x4 __attribute__((ext_vector_type(4)));
__device__ __forceinline__ f32x4 mfma16(bf16x8 a, bf16x8 b, f32x4 c) { return __builtin_amdgcn_mfma_f32_16x16x32_bf16(a, b, c, 0, 0, 0); }
__device__ __forceinline__ bf16x8 ld8(const LAS unsigned char* p) { return *(const LAS bf16x8*)p; }
__device__ __forceinline__ float logsig(float z) { return fminf(z, 0.f) - __logf(1.0f + __expf(-fabsf(z))); }

__device__ __forceinline__ void item(const Args& a, LAS unsigned char* lds, int b, int h, int vs, int tid) {
    const int wave = __builtin_amdgcn_readfirstlane(tid >> 6), lane = tid & 63;
    unsigned char* ws = a.ws;
    const bf16* GQ = (const bf16*)(ws + WS_GQ); const bf16* GK = (const bf16*)(ws + WS_GK); bf16* GV = (bf16*)(ws + WS_GV); const float* GLOW = (const float*)(ws + WS_GLOW);
    const float* wup = a.in[4]; const float* bgk = a.in[5];
    const int d0 = 2 * lane;
    float wu0[16], wu1[16];
#pragma unroll
    for (int r = 0; r < 16; ++r) { const f32x2v t = *(const f32x2v*)(wup + r * 512 + h * 128 + d0); wu0[r] = t.x; wu1[r] = t.y; }
    const f32x2v bg = *(const f32x2v*)(bgk + h * 128 + d0);
    const size_t row0 = (size_t)b * SEQ;
    for (int e = tid; e < 64 * PQ / 2; e += NTHR) ((LAS unsigned*)(lds + O_SB))[e] = 0u;
    f32x4 S[4];
#pragma unroll
    for (int t = 0; t < 4; ++t) S[t] = (f32x4){0.f, 0.f, 0.f, 0.f};
    unsigned pq[8], pk[8]; unsigned short pv[8]; f32x4 pgl = {0.f, 0.f, 0.f, 0.f};
    auto prefetch = [&](int n) {
        const size_t r0 = row0 + (size_t)n * C + 8 * wave;
#pragma unroll
        for (int i = 0; i < 8; ++i) { pq[i] = *(const unsigned*)(GQ + (r0 + i) * 512 + h * 128 + d0); pk[i] = *(const unsigned*)(GK + (r0 + i) * 512 + h * 128 + d0);
            pv[i] = GV[(r0 + i) * 1024 + h * 256 + vs * 64 + lane]; }
        if (tid < 256) pgl = *(const f32x4*)(GLOW + (row0 + (size_t)n * C) * 16 + tid * 4);
    };
    prefetch(0);
    if (tid < 256) *(LAS f32x4*)(lds + O_GL + tid * 16) = pgl;
    __syncthreads();
    const float qs = 0.08838834764831845f;
    for (int n = 0; n < NCH; ++n) {
        float g0[8], g1[8];
#pragma unroll
        for (int i = 0; i < 8; ++i) { const LAS f32x4* gp = (const LAS f32x4*)(lds + O_GL + (8 * wave + i) * 64); float z0 = bg.x, z1 = bg.y;
#pragma unroll
            for (int r4 = 0; r4 < 4; ++r4) { const f32x4 gl = gp[r4];
#pragma unroll
                for (int j = 0; j < 4; ++j) { z0 += gl[j] * wu0[4 * r4 + j]; z1 += gl[j] * wu1[4 * r4 + j]; } }
            g0[i] = logsig(z0) * 0.0625f; g1[i] = logsig(z1) * 0.0625f; }
        const float first0 = g0[0], first1 = g1[0];
#pragma unroll
        for (int i = 1; i < 8; ++i) { g0[i] += g0[i - 1]; g1[i] += g1[i - 1]; }
        LAS float* T = (LAS float*)(lds + O_T + (n & 1) * 10 * 128 * 4);
        *(LAS f32x2v*)(T + wave * 128 + d0) = (f32x2v){g0[7], g1[7]};
        if (wave == 4) *(LAS f32x2v*)(T + 8 * 128 + d0) = (f32x2v){first0, first1};
        unsigned cq[8], ck[8]; unsigned short cv[8];
#pragma unroll
        for (int i = 0; i < 8; ++i) { cq[i] = pq[i]; ck[i] = pk[i]; cv[i] = pv[i]; }
        __syncthreads();
        if (n + 1 < NCH) prefetch(n + 1);
        float pre0 = 0.f, pre1 = 0.f, mid0 = 0.f, mid1 = 0.f, tot0 = 0.f, tot1 = 0.f;
#pragma unroll
        for (int w = 0; w < 8; ++w) { const f32x2v t = *(const LAS f32x2v*)(T + w * 128 + d0); if (w < wave) { pre0 += t.x; pre1 += t.y; } if (w < 4) { mid0 += t.x; mid1 += t.y; } tot0 += t.x; tot1 += t.y; }
        { const f32x2v t = *(const LAS f32x2v*)(T + 8 * 128 + d0); mid0 += t.x; mid1 += t.y; }
        const float em0 = __expf(-mid0), em1 = __expf(-mid1), ep0 = __expf(mid0), ep1 = __expf(mid1), el0 = __expf(tot0), el1 = __expf(tot1);
        if (wave == 0) *(LAS f32x2v*)(lds + O_DEC + d0 * 4) = (f32x2v){el0, el1};
        unsigned kst0[4], kst1[4];
#pragma unroll
        for (int i = 0; i < 8; ++i) {
            const float G0 = pre0 + g0[i], G1 = pre1 + g1[i];
            const float E0 = __expf(G0), E1 = __expf(G1), R0 = __builtin_amdgcn_rcpf(E0), R1 = __builtin_amdgcn_rcpf(E1);
            const float q0 = bflo(cq[i]) * qs, q1 = bfhi(cq[i]) * qs, k0 = bflo(ck[i]), k1 = bfhi(ck[i]);
            const int row = 8 * wave + i;
            *(LAS unsigned*)(lds + O_QIN + (row * PQ + d0) * 2) = pk2(q0 * E0, q1 * E1);
            *(LAS unsigned*)(lds + O_QI + (row * PQ + d0) * 2) = pk2(q0 * E0 * em0, q1 * E1 * em1);
            *(LAS unsigned*)(lds + O_KJ + (row * PQ + d0) * 2) = pk2(k0 * R0 * ep0, k1 * R1 * ep1);
            const unsigned a0 = f2bf(k0 * R0 * el0), a1 = f2bf(k1 * R1 * el1);
            if (i & 1) { kst0[i >> 1] |= a0 << 16; kst1[i >> 1] |= a1 << 16; } else { kst0[i >> 1] = a0; kst1[i >> 1] = a1; }
        }
        *(LAS v4u*)(lds + O_KST + (d0 * PJ + 8 * wave) * 2) = (v4u){kst0[0], kst0[1], kst0[2], kst0[3]};
        *(LAS v4u*)(lds + O_KST + ((d0 + 1) * PJ + 8 * wave) * 2) = (v4u){kst1[0], kst1[1], kst1[2], kst1[3]};
        { v4u vv; vv.x = cv[0] | ((unsigned)cv[1] << 16); vv.y = cv[2] | ((unsigned)cv[3] << 16); vv.z = cv[4] | ((unsigned)cv[5] << 16); vv.w = cv[6] | ((unsigned)cv[7] << 16);
          *(LAS v4u*)(lds + O_VT + (lane * PJ + 8 * wave) * 2) = vv; }
        __syncthreads();
        if (n + 1 < NCH && tid < 256) *(LAS f32x4*)(lds + O_GL + tid * 16) = pgl;
        const int fr = lane & 15, fq = lane >> 4;
        { const int it = wave >> 1;
#pragma unroll
          for (int jj = 0; jj < 2; ++jj) { const int jt = 2 * (wave & 1) + jj; f32x4 acc = {0.f, 0.f, 0.f, 0.f};
#pragma unroll
              for (int ks = 0; ks < 4; ++ks) acc = mfma16(ld8(lds + O_KJ + ((16 * jt + fr) * PQ + ks * 32 + fq * 8) * 2), ld8(lds + O_QI + ((16 * it + fr) * PQ + ks * 32 + fq * 8) * 2), acc);
              const int i = 16 * it + fr, j0 = 16 * jt + 4 * fq;
#pragma unroll
              for (int e = 0; e < 4; ++e) if (j0 + e > i) acc[e] = 0.f;
              *(LAS v2u*)(lds + O_AM + (i * PJ + j0) * 2) = (v2u){pk2(acc[0], acc[1]), pk2(acc[2], acc[3])}; } }
        __syncthreads();
        { const int ct = wave >> 1; const LAS unsigned char* SB = lds + O_SB + (n & 1) * 64 * PQ * 2;
#pragma unroll
          for (int ii = 0; ii < 2; ++ii) { const int it = 2 * (wave & 1) + ii; f32x4 acc = {0.f, 0.f, 0.f, 0.f};
#pragma unroll
              for (int ks = 0; ks < 2; ++ks) acc = mfma16(ld8(lds + O_VT + ((16 * ct + fr) * PJ + ks * 32 + fq * 8) * 2), ld8(lds + O_AM + ((16 * it + fr) * PJ + ks * 32 + fq * 8) * 2), acc);
#pragma unroll
              for (int ks = 0; ks < 4; ++ks) acc = mfma16(ld8(SB + ((16 * ct + fr) * PQ + ks * 32 + fq * 8) * 2), ld8(lds + O_QIN + ((16 * it + fr) * PQ + ks * 32 + fq * 8) * 2), acc);
              const size_t grow = row0 + (size_t)n * C + 16 * it + fr;
              *(v2u*)(GV + grow * 1024 + h * 256 + vs * 64 + 16 * ct + 4 * fq) = (v2u){pk2(acc[0], acc[1]), pk2(acc[2], acc[3])}; } }
        { const f32x4 dec = *(const LAS f32x4*)(lds + O_DEC + (16 * wave + 4 * fq) * 4); LAS unsigned char* SBn = lds + O_SB + ((n + 1) & 1) * 64 * PQ * 2;
          const bf16x8 ka0 = ld8(lds + O_KST + ((16 * wave + fr) * PJ + fq * 8) * 2), ka1 = ld8(lds + O_KST + ((16 * wave + fr) * PJ + 32 + fq * 8) * 2);
#pragma unroll
          for (int ct = 0; ct < 4; ++ct) { f32x4 s = S[ct] * dec;
              s = mfma16(ka0, ld8(lds + O_VT + ((16 * ct + fr) * PJ + fq * 8) * 2), s);
              s = mfma16(ka1, ld8(lds + O_VT + ((16 * ct + fr) * PJ + 32 + fq * 8) * 2), s);
              S[ct] = s;
              *(LAS v2u*)(SBn + ((16 * ct + fr) * PQ + 16 * wave + 4 * fq) * 2) = (v2u){pk2(s[0], s[1]), pk2(s[2], s[3])}; } }
    }
    __syncthreads();
}
}

__device__ __forceinline__ void p3_norms(const Args& a, int gw, int NGW, int lane) {
    unsigned char* ws = a.ws; bf16* OA = (bf16*)(ws + WS_GV); const bf16* SOG = (const bf16*)(ws + WS_SOG); bf16* OB = (bf16*)(ws + WS_U);
    const float* wa = a.in[6]; const float* wb = a.in[11];
    float wav[16], wbv[16];
#pragma unroll
    for (int j = 0; j < 16; ++j) { wav[j] = wa[(16 * lane + j) & 255]; wbv[j] = wb[(16 * lane + j) & 127] * 0.8f; }
    for (int m = gw; m < M; m += NGW) {
        { v4u* p = (v4u*)(OA + (size_t)m * D + 16 * lane); const v4u* g = (const v4u*)(SOG + (size_t)m * D + 16 * lane);
          const v4u x0 = p[0], x1 = p[1], g0 = g[0], g1 = g[1]; float v[16], gg[16];
          const unsigned xs[8] = {x0.x, x0.y, x0.z, x0.w, x1.x, x1.y, x1.z, x1.w}, gs[8] = {g0.x, g0.y, g0.z, g0.w, g1.x, g1.y, g1.z, g1.w};
          float s = 0.f;
#pragma unroll
          for (int j = 0; j < 8; ++j) { v[2 * j] = bflo(xs[j]); v[2 * j + 1] = bfhi(xs[j]); gg[2 * j] = bflo(gs[j]); gg[2 * j + 1] = bfhi(gs[j]); s += v[2 * j] * v[2 * j] + v[2 * j + 1] * v[2 * j + 1]; }
          s += __shfl_xor(s, 1); s += __shfl_xor(s, 2); s += __shfl_xor(s, 4); s += __shfl_xor(s, 8);
          const float rstd = rsqrtf(s * (1.f / 256.f) + EPS); unsigned o[8];
#pragma unroll
          for (int j = 0; j < 8; ++j) o[j] = pk2(v[2 * j] * rstd * wav[2 * j] * gg[2 * j], v[2 * j + 1] * rstd * wav[2 * j + 1] * gg[2 * j + 1]);
          p[0] = (v4u){o[0], o[1], o[2], o[3]}; p[1] = (v4u){o[4], o[5], o[6], o[7]}; }
        { v4u* p = (v4u*)(OB + (size_t)m * D + 16 * lane); const v4u x0 = p[0], x1 = p[1]; float v[16];
          const unsigned xs[8] = {x0.x, x0.y, x0.z, x0.w, x1.x, x1.y, x1.z, x1.w}; float s = 0.f;
#pragma unroll
          for (int j = 0; j < 8; ++j) { v[2 * j] = bflo(xs[j]); v[2 * j + 1] = bfhi(xs[j]); s += v[2 * j] * v[2 * j] + v[2 * j + 1] * v[2 * j + 1]; }
          s += __shfl_xor(s, 1); s += __shfl_xor(s, 2); s += __shfl_xor(s, 4);
          const float rstd = rsqrtf(s * (1.f / 128.f) + EPS); unsigned o[8];
#pragma unroll
          for (int j = 0; j < 8; ++j) o[j] = pk2(v[2 * j] * rstd * wbv[2 * j], v[2 * j + 1] * rstd * wbv[2 * j + 1]);
          p[0] = (v4u){o[0], o[1], o[2], o[3]}; p[1] = (v4u){o[4], o[5], o[6], o[7]}; }
    }
}
__device__ __forceinline__ void p5b_resid_norm(const Args& a, int gw, int NGW, int lane) {
    unsigned char* ws = a.ws; const float* MX = (const float*)(ws + WS_MIXED); bf16* H = (bf16*)(ws + WS_U);
    const float* x = a.in[0]; const float* w1 = a.in[16]; const float* w2 = a.in[17];
    for (int m = gw; m < M; m += NGW) { const f32x4* mr = (const f32x4*)(MX + (size_t)m * D) + lane; const f32x4* xr = (const f32x4*)(x + (size_t)m * D) + lane; f32x4* orow = (f32x4*)(a.out + (size_t)m * D) + lane;
        f32x4 v[4]; float s = 0.f;
#pragma unroll
        for (int j = 0; j < 4; ++j) { v[j] = mr[64 * j]; s += (v[j].x * v[j].x + v[j].y * v[j].y) + (v[j].z * v[j].z + v[j].w * v[j].w); }
        const float rstd = rsqrtf(wave_sum(s) * (1.f / D) + EPS); float s2 = 0.f;
#pragma unroll
        for (int j = 0; j < 4; ++j) { v[j] = xr[64 * j] + v[j] * rstd * ((const f32x4*)w1)[64 * j + lane]; orow[64 * j] = v[j]; s2 += (v[j].x * v[j].x + v[j].y * v[j].y) + (v[j].z * v[j].z + v[j].w * v[j].w); }
        const float rstd2 = rsqrtf(wave_sum(s2) * (1.f / D) + EPS);
        unsigned long long* o8 = (unsigned long long*)(H + (size_t)m * D) + lane;
#pragma unroll
        for (int j = 0; j < 4; ++j) { const f32x4 t = v[j] * rstd2 * ((const f32x4*)w2)[64 * j + lane]; o8[64 * j] = (unsigned long long)pk2(t.x, t.y) | ((unsigned long long)pk2(t.z, t.w) << 32); } }
}
__device__ __forceinline__ void p7b_final(const Args& a, int gw, int NGW, int lane) {
    const float* F = (const float*)(a.ws + WS_F); const float* w = a.in[18];
    for (int m = gw; m < M; m += NGW) { const f32x4* fr = (const f32x4*)(F + (size_t)m * D) + lane; f32x4* orow = (f32x4*)(a.out + (size_t)m * D) + lane;
        f32x4 v[4]; float s = 0.f;
#pragma unroll
        for (int j = 0; j < 4; ++j) { v[j] = fr[64 * j]; s += (v[j].x * v[j].x + v[j].y * v[j].y) + (v[j].z * v[j].z + v[j].w * v[j].w); }
        const float rstd = rsqrtf(wave_sum(s) * (1.f / D) + EPS);
#pragma unroll
        for (int j = 0; j < 4; ++j) orow[64 * j] = orow[64 * j] + v[j] * rstd * ((const f32x4*)w)[64 * j + lane]; }
}

__global__ void __launch_bounds__(NTHR, 2) fwd_megakernel(Args args) {
    extern __shared__ __attribute__((aligned(16))) unsigned char lds_raw[];
    cg::grid_group grid = cg::this_grid();
    LAS unsigned char* lds = (LAS unsigned char*)lds_raw;
#define FRESH_TID() int tid = threadIdx.x; asm volatile("" : "+v"(tid)); const int lane = tid & 63, wave = __builtin_amdgcn_readfirstlane(tid >> 6); const int gw = vcu * NWAVES + wave; (void)lane; (void)gw
    const int G = gridDim.x, bx = blockIdx.x; const int vcu = (G % 8 == 0) ? (bx % 8) * (G / 8) + bx / 8 : bx;
    const int NGW = G * NWAVES;
    unsigned char* ws = args.ws;
    bf16* W1t = (bf16*)(ws + WS_W1); bf16* U = (bf16*)(ws + WS_U);
    bf16* GATES = (bf16*)args.out;

    { FRESH_TID(); p0_prologue(args, lds, gw, NGW, wave, lane); }
    grid.sync();
#ifndef NO_P1
    { pg8::Gemm g{U, W1t, M, N1, D}; pg8::StaticOrder S; S.init(M, N1, G, bx);
      pg8::EpiP1 E{(bf16*)(ws + WS_GQ), (bf16*)(ws + WS_GK), (bf16*)(ws + WS_GV), (bf16*)(ws + WS_SOG), (bf16*)(ws + WS_DQ), (bf16*)(ws + WS_DK), (bf16*)(ws + WS_DV), GATES,
                   (float*)(ws + WS_GLOW), (const float*)(ws + WS_ROPE), args.in[3], attn_body::C2};
      pg8::gemm_phase<pg8::EpiP1, pg8::StaticOrder, PG8_ALIGN, PG8_SP2>(lds, g, S, E); }
#endif
    grid.sync();
#ifndef NO_GLA
    { FRESH_TID(); for (int it = vcu; it < BATCH * 4 * 4; it += G) gla::item(args, lds, it >> 4, (it >> 2) & 3, it & 3, tid); }
#endif
#ifndef NO_ATTN
    { FRESH_TID(); float lam;
      { const float p1 = wave_sum(args.in[7][lane] * args.in[8][lane]), p2 = wave_sum(args.in[9][lane] * args.in[10][lane]); lam = __uint_as_float(__builtin_amdgcn_readfirstlane(__float_as_uint(expf(p1) - expf(p2) + 0.2f))); }
      const attn_body::AttnTensors AT{(const attn_body::bf16*)(ws + WS_DQ), (const attn_body::bf16*)(ws + WS_DK), (const attn_body::bf16*)(ws + WS_DV), (attn_body::bf16*)(ws + WS_U)};
      attn_body::attn_phase<8>((char*)lds_raw, AT, vcu, G, lam); }
#endif
    grid.sync();
    { FRESH_TID(); p3_norms(args, gw, NGW, lane); }
    grid.sync();
#ifndef NO_REST
    { pg8::StaticOrder S; S.init(M, D, G, bx);
      { pg8::Gemm g{(bf16*)(ws + WS_GV), (bf16*)(ws + WS_WA), M, D, D}; pg8::EpiN<0> E{(bf16*)(ws + WS_T), nullptr, D, GATES, 0, nullptr};
        pg8::gemm_phase<pg8::EpiN<0>, pg8::StaticOrder, PG8_ALIGN, PG8_SP2>(lds, g, S, E); }
      __syncthreads();
      { pg8::Gemm g{(bf16*)(ws + WS_U), (bf16*)(ws + WS_WB), M, D, D}; pg8::EpiN<1> E{(bf16*)(ws + WS_MIXIN), nullptr, D, GATES, 1024, (const bf16*)(ws + WS_T)};
        pg8::gemm_phase<pg8::EpiN<1>, pg8::StaticOrder, PG8_ALIGN, PG8_SP2>(lds, g, S, E); } }
    grid.sync();
    { pg8::Gemm g{(bf16*)(ws + WS_MIXIN), (bf16*)(ws + WS_WO), M, D, D}; pg8::StaticOrder S; S.init(M, D, G, bx); pg8::EpiN<2> E{nullptr, (float*)(ws + WS_MIXED), D, nullptr, 0, nullptr};
      pg8::gemm_phase<pg8::EpiN<2>, pg8::StaticOrder, PG8_ALIGN, PG8_SP2>(lds, g, S, E); }
    grid.sync();
    { FRESH_TID(); p5b_resid_norm(args, gw, NGW, lane); }
    grid.sync();
    { pg8::Gemm g{(bf16*)(ws + WS_U), (bf16*)(ws + WS_WUP), M, FF, D}; pg8::StaticOrder S; S.init(M, FF, G, bx); pg8::EpiN<3> E{(bf16*)(ws + WS_HMID), nullptr, FF, nullptr, 0, nullptr};
      pg8::gemm_phase<pg8::EpiN<3>, pg8::StaticOrder, PG8_ALIGN, PG8_SP2>(lds, g, S, E); }
    grid.sync();
    { pg8::Gemm g{(bf16*)(ws + WS_HMID), (bf16*)(ws + WS_WDN), M, D, FF}; pg8::StaticOrder S; S.init(M, D, G, bx); pg8::EpiN<2> E{nullptr, (float*)(ws + WS_F), D, nullptr, 0, nullptr};
      pg8::gemm_phase<pg8::EpiN<2>, pg8::StaticOrder, PG8_ALIGN, PG8_SP2>(lds, g, S, E); }
    grid.sync();
    { FRESH_TID(); p7b_final(args, gw, NGW, lane); }
#endif
}

extern "C" void kernel_launch(void* const* d_in, const int* in_sizes, int n_in, void* d_out, int out_size, void* d_ws, size_t ws_size, hipStream_t stream) {
    static int grid = 0;
    if (grid == 0) {
        if (n_in != 21 || in_sizes[0] != M * D || out_size != M * D || ws_size < WS_END) { fprintf(stderr, "kernel_launch: unexpected shapes (n_in %d, in0 %d, out %d, ws %zu)\n", n_in, n_in > 0 ? in_sizes[0] : -1, out_size, ws_size); grid = -1; return; }
        int dev = 0, cus = 0, per_cu = 0;
        hipGetDevice(&dev); hipDeviceGetAttribute(&cus, hipDeviceAttributeMultiprocessorCount, dev);
        if (hipFuncSetAttribute((const void*)fwd_megakernel, hipFuncAttributeMaxDynamicSharedMemorySize, LDS_BYTES) != hipSuccess) { fprintf(stderr, "kernel_launch: hipFuncSetAttribute failed\n"); grid = -1; return; }
        if (hipOccupancyMaxActiveBlocksPerMultiprocessor(&per_cu, (const void*)fwd_megakernel, NTHR, LDS_BYTES) != hipSuccess || per_cu < 1) { fprintf(stderr, "kernel_launch: occupancy query says %d\n", per_cu); per_cu = 1; }
        (void)hipGetLastError();
        grid = cus * per_cu;
    }
    if (grid < 0) return;
    Args a{};
    for (int i = 0; i < 21; ++i) a.in[i] = (const float*)d_in[i];
    a.out = (float*)d_out; a.ws = (unsigned char*)d_ws;
    void* kargs[] = {&a};
    hipError_t e = hipLaunchCooperativeKernel((const void*)fwd_megakernel, dim3(grid), dim3(NTHR), kargs, LDS_BYTES, stream);
    if (e != hipSuccess) fprintf(stderr, "cooperative launch failed: %s (grid %d)\n", hipGetErrorString(e), grid);
}
```

```cpp
#include <hip/hip_runtime.h>
#include <hip/hip_cooperative_groups.h>
#include <hip/hip_bf16.h>
#include <cstdio>
#include <cstdint>
#include <cmath>
namespace cg = cooperative_groups;
namespace pg8 {
#define PG8_LAS __attribute__((address_space(3)))
typedef unsigned short bf16_t;
typedef short bf16x8 __attribute__((ext_vector_type(8)));
typedef float f32x4 __attribute__((ext_vector_type(4)));
typedef unsigned u32x4 __attribute__((ext_vector_type(4)));
constexpr int BM = 256, BK = 64, HALF = 128, HTB = HALF * BK * 2  , STAGE_BYTES = 8 * HTB, NXCD = 8, WGM = 8;

__host__ __device__ __forceinline__ int lds_byte(int r, int c) { const int st = (r >> 4) * 2 + (c >> 5), rr = r & 15, cc = c & 31, ob = rr * 64 + cc * 2; return st * 1024 + (ob ^ (((ob >> 9) & 1) << 5)); }
__host__ __device__ __forceinline__ void stage_rc(int b, int& R, int& C) { const int st = b / 1024, sb = b % 1024, swz = sb ^ (((sb >> 9) & 1) << 5); R = (st >> 1) * 16 + swz / 64; C = (st & 1) * 32 + (swz % 64) / 2; }
__host__ __device__ __forceinline__ int perm32(int rho) { const int n = rho >> 4, i = rho & 15; return 8 * (i >> 2) + 4 * n + (i & 3); }

struct Unit { int pm, pn; };
struct Gemm { const bf16_t* A; const bf16_t* Bt; int M, N, K; };

struct StaticOrder {
    int nM, nN, nwg, G, c;
    __host__ __device__ void init(int M, int N, int G_, int c_) { nM = M / BM; nN = N / BM; nwg = nM * nN; G = G_; c = c_; }
    __host__ __device__ bool next(int i, Unit& u) const {
        const long L = (long)i * G + c; if (L >= nwg) return false;
        int wgid = (int)L; { const int q = nwg / NXCD, r = nwg % NXCD, xcd = wgid % NXCD, off = wgid / NXCD; wgid = (xcd < r ? xcd * (q + 1) : r * (q + 1) + (xcd - r) * q) + off; }
        const int nig = WGM * nN, gid = wgid / nig, fm = gid * WGM, gsz = (nM - fm) < WGM ? (nM - fm) : WGM;
        u.pm = fm + ((wgid % nig) % gsz); u.pn = (wgid % nig) / gsz; return true;
    }
    __device__ __forceinline__ void a_ready(const Unit&) const {}
    __device__ __forceinline__ void done(const Unit&) const {}
};

__device__ __forceinline__ unsigned cvt_pk_bf16(float lo, float hi) { unsigned r; asm volatile("v_cvt_pk_bf16_f32 %0, %1, %2" : "=v"(r) : "v"(lo), "v"(hi)); return r; }
typedef float f32x2 __attribute__((ext_vector_type(2)));

__device__ __forceinline__ float sigmoidf_(float v) { return __builtin_amdgcn_rcpf(1.0f + __expf(-v)); }
__device__ __forceinline__ float bf_lo(unsigned w) { return __uint_as_float(w << 16); }
__device__ __forceinline__ float bf_hi(unsigned w) { return __uint_as_float(w & 0xffff0000u); }
__device__ __forceinline__ u32x4 pack8(const f32x4 a, const f32x4 b) { u32x4 w; w.x = cvt_pk_bf16(a[0], a[1]); w.y = cvt_pk_bf16(a[2], a[3]); w.z = cvt_pk_bf16(b[0], b[1]); w.w = cvt_pk_bf16(b[2], b[3]); return w; }

struct EpiP1 {
    static constexpr bool PERM = true, AFTER_DRAIN = false;
    bf16_t *GQ, *GK, *GV, *SOG, *DQ, *DK, *DV, *GATES; float* GLOW; const float* ROPE; const float* b_gate; float qscale;
    __device__ __forceinline__ void operator()(const f32x4 (&acc)[2][2][4][2], const Unit& u, int wr, int wc, int fr, int fq) const {
        const int pn = u.pn; const int row0 = u.pm * BM + wr * 64 + fr; const int cl = wc * 32 + 8 * fq;
        if (pn == 32) {
            if (wc == 0 && fq < 2) {
#pragma unroll
                for (int ai = 0; ai < 2; ++ai)
#pragma unroll
                    for (int m = 0; m < 4; ++m) { float* p = GLOW + (size_t)(row0 + ai * HALF + m * 16) * 16 + 8 * fq;
                        *(f32x4*)p = acc[ai][0][m][0]; *(f32x4*)(p + 4) = acc[ai][0][m][1]; }
            }
            return;
        }
        bf16_t* base; int ld, colt, mode = 0;
        if (pn < 2) { base = GQ; ld = 512; colt = pn * 256; }
        else if (pn < 4) { base = GK; ld = 512; colt = (pn - 2) * 256; }
        else if (pn < 8) { base = GV; ld = 1024; colt = (pn - 4) * 256; }
        else if (pn < 12) { base = SOG; ld = 1024; colt = (pn - 8) * 256; mode = 1; }
        else if (pn < 16) { base = DQ; ld = 1024; colt = (pn - 12) * 256; mode = 2; }
        else if (pn < 20) { base = DK; ld = 1024; colt = (pn - 16) * 256; mode = 2; }
        else if (pn < 24) { base = DV; ld = 1024; colt = (pn - 20) * 256; }
        else { base = GATES; ld = 2048; colt = (pn - 24) * 256; mode = 3; }
        const float sc = (pn >= 12 && pn < 16) ? qscale : 1.0f;
        if (mode == 2) {
            const bool ropew = (wc & 1) == 0;
#pragma unroll
            for (int ai = 0; ai < 2; ++ai)
#pragma unroll
                for (int m = 0; m < 4; ++m) { const int row = row0 + ai * HALF + m * 16; bf16_t* rowp = base + (size_t)row * ld + colt + cl;
                    f32x4 c0 = {1.f, 1.f, 1.f, 1.f}, c1 = c0, s0 = {0.f, 0.f, 0.f, 0.f}, s1 = s0;
                    if (ropew) { const f32x4* rp = (const f32x4*)(ROPE + (size_t)row * 16); c0 = rp[0]; c1 = rp[1]; s0 = rp[2]; s1 = rp[3]; }
#pragma unroll
                    for (int bj = 0; bj < 2; ++bj) { f32x4 v0 = acc[ai][bj][m][0], v1 = acc[ai][bj][m][1];
                        if (ropew) { f32x4 p0, p1;
#pragma unroll
                            for (int j = 0; j < 4; ++j) { p0[j] = __shfl_xor(v0[j], 16); p1[j] = __shfl_xor(v1[j], 16); }
                            if (fq == 0) { v0 = v0 * c0 - p0 * s0; v1 = v1 * c1 - p1 * s1; }
                            else if (fq == 1) { v0 = v0 * c0 + p0 * s0; v1 = v1 * c1 + p1 * s1; } }
                        v0 = v0 * sc; v1 = v1 * sc;
                        *(u32x4*)(rowp + bj * HALF) = pack8(v0, v1); } }
            return;
        }
        f32x4 bv[2][2];
#pragma unroll
        for (int bj = 0; bj < 2; ++bj)
#pragma unroll
            for (int n = 0; n < 2; ++n) bv[bj][n] = (mode == 3) ? *(const f32x4*)(b_gate + colt + cl + bj * HALF + 4 * n) : (f32x4){0.f, 0.f, 0.f, 0.f};
#pragma unroll
        for (int ai = 0; ai < 2; ++ai)
#pragma unroll
            for (int m = 0; m < 4; ++m) { bf16_t* rowp = base + (size_t)(row0 + ai * HALF + m * 16) * ld + colt + cl;
#pragma unroll
                for (int bj = 0; bj < 2; ++bj) { f32x4 v0 = acc[ai][bj][m][0] + bv[bj][0], v1 = acc[ai][bj][m][1] + bv[bj][1];
                    if (mode == 1) {
#pragma unroll
                        for (int j = 0; j < 4; ++j) { v0[j] = v0[j] * sigmoidf_(v0[j]); v1[j] = v1[j] * sigmoidf_(v1[j]); } }
                    else if (mode == 3) {
#pragma unroll
                        for (int j = 0; j < 4; ++j) { v0[j] = sigmoidf_(v0[j]); v1[j] = sigmoidf_(v1[j]); } }
                    *(u32x4*)(rowp + bj * HALF) = pack8(v0, v1); } }
    }
};

template <int MODE> struct EpiN {
    static constexpr bool PERM = true, AFTER_DRAIN = false;
    bf16_t* O; float* OF; int ldc; const bf16_t* G; int goff; const bf16_t* T;
    __device__ __forceinline__ void operator()(const f32x4 (&acc)[2][2][4][2], const Unit& u, int wr, int wc, int fr, int fq) const {
        const int row0 = u.pm * BM + wr * 64 + fr; const int col0 = u.pn * BM + wc * 32 + 8 * fq;
#pragma unroll
        for (int ai = 0; ai < 2; ++ai)
#pragma unroll
            for (int m = 0; m < 4; ++m) { const size_t row = (size_t)(row0 + ai * HALF + m * 16);
#pragma unroll
                for (int bj = 0; bj < 2; ++bj) { f32x4 v0 = acc[ai][bj][m][0], v1 = acc[ai][bj][m][1]; const int col = col0 + bj * HALF;
                    if (MODE == 0 || MODE == 1) { const u32x4 g = *(const u32x4*)(G + row * 2048 + goff + col);
                        v0 = v0 * (f32x4){bf_lo(g.x), bf_hi(g.x), bf_lo(g.y), bf_hi(g.y)}; v1 = v1 * (f32x4){bf_lo(g.z), bf_hi(g.z), bf_lo(g.w), bf_hi(g.w)}; }
                    if (MODE == 1) { const u32x4 t = *(const u32x4*)(T + row * ldc + col);
                        v0 = v0 + (f32x4){bf_lo(t.x), bf_hi(t.x), bf_lo(t.y), bf_hi(t.y)}; v1 = v1 + (f32x4){bf_lo(t.z), bf_hi(t.z), bf_lo(t.w), bf_hi(t.w)}; }
                    if (MODE == 3) {
#pragma unroll
                        for (int j = 0; j < 4; ++j) { const float a = fmaxf(v0[j], 0.f), b = fmaxf(v1[j], 0.f); v0[j] = a * a; v1[j] = b * b; } }
                    if (MODE == 2) { float* p = OF + row * ldc + col; *(f32x4*)p = v0; *(f32x4*)(p + 4) = v1; }
                    else *(u32x4*)(O + row * ldc + col) = pack8(v0, v1); } }
    }
};
template <class Epi, class Sched, bool ALIGN_EPI = false, bool SP2 = false>
__device__ __forceinline__ void gemm_phase(PG8_LAS unsigned char* lds, const Gemm g, const Sched& S, const Epi& E) {
    int tid_ = threadIdx.x; asm volatile("" : "+v"(tid_)); const int tid = tid_, wid = __builtin_amdgcn_readfirstlane(tid >> 6), lane = tid & 63, wr = wid >> 2, wc = wid & 3, fr = lane & 15, fq = lane >> 4;
    const int K = g.K, nt = K / BK;
    unsigned voffA[2], voffB[2];
#pragma unroll
    for (int i = 0; i < 2; ++i) { int R, C; stage_rc(tid * 16 + i * 8192, R, C); const int Rb = Epi::PERM ? ((R & ~31) + perm32(R & 31)) : R;
        voffA[i] = (unsigned)(R * K + C) * 2u; voffB[i] = (unsigned)(Rb * K + C) * 2u; }
    const size_t kstep = (size_t)(BK * 2);
    const size_t hstep = (size_t)HALF * K * 2;
    const size_t tstep = 2 * hstep;
    const unsigned ldsw = (unsigned)wid * 1024u;
    const int aoff = lds_byte(wr * 64 + fr, fq * 8), boff = lds_byte(wc * 32 + fr, fq * 8);
#define PG8_SA(b, h) (((b) * 2 + (h)) * HTB)
#define PG8_SB(b, h) ((4 + (b) * 2 + (h)) * HTB)
#define PG8_STAGE(bufoff, gbase, voff) do { _Pragma("unroll") for (int _i = 0; _i < 2; ++_i) \
        __builtin_amdgcn_global_load_lds((const unsigned*)((const char*)(gbase) + (voff)[_i]), (PG8_LAS unsigned*)(lds + (bufoff) + ldsw + _i * 8192), 16, 0, 0); } while (0)
#define PG8_LDA(dst, b, h) do { _Pragma("unroll") for (int m = 0; m < 4; ++m) _Pragma("unroll") for (int k = 0; k < 2; ++k) dst[m][k] = *(const PG8_LAS bf16x8*)(lds + PG8_SA(b, h) + aoff + m * 2048 + k * 1024); } while (0)
#define PG8_LDB(dst, b, h) do { _Pragma("unroll") for (int n = 0; n < 2; ++n) _Pragma("unroll") for (int k = 0; k < 2; ++k) dst[n][k] = *(const PG8_LAS bf16x8*)(lds + PG8_SB(b, h) + boff + n * 2048 + k * 1024); } while (0)
#define PG8_MMA(ai, bj, At, Bt) do { __builtin_amdgcn_s_setprio(1); _Pragma("unroll") for (int m = 0; m < 4; ++m) _Pragma("unroll") for (int n = 0; n < 2; ++n) _Pragma("unroll") for (int k = 0; k < 2; ++k) \
        acc[ai][bj][m][n] = __builtin_amdgcn_mfma_f32_16x16x32_bf16(Bt[n][k], At[m][k], acc[ai][bj][m][n], 0, 0, 0); __builtin_amdgcn_s_setprio(0); } while (0)
#define PG8_WAIT_V(n) asm volatile("s_waitcnt vmcnt(" #n ")" ::: "memory")
#define PG8_WAIT_L(n) asm volatile("s_waitcnt lgkmcnt(" #n ")" ::: "memory")
#define PG8_BAR __builtin_amdgcn_s_barrier()
#define PG8_SCHED __builtin_amdgcn_sched_barrier(0)
    Unit cur, nxt; int ui = 0;
    if (!S.next(0, cur)) return;
    f32x4 acc[2][2][4][2];
#pragma unroll
    for (int a = 0; a < 2; ++a)
#pragma unroll
        for (int b = 0; b < 2; ++b)
#pragma unroll
            for (int m = 0; m < 4; ++m)
#pragma unroll
                for (int n = 0; n < 2; ++n) acc[a][b][m][n] = (f32x4){0.f, 0.f, 0.f, 0.f};
    bf16x8 At[4][2], B0[2][2], B1[2][2];
    const char* cA = (const char*)g.A + (size_t)cur.pm * tstep; const char* cB = (const char*)g.Bt + (size_t)cur.pn * tstep;
    S.a_ready(cur);
    if constexpr (SP2) {
        PG8_STAGE(PG8_SB(0, 0), cB, voffB); PG8_STAGE(PG8_SB(0, 1), cB + hstep, voffB); PG8_STAGE(PG8_SA(0, 0), cA, voffA); PG8_STAGE(PG8_SA(0, 1), cA + hstep, voffA);
        if (wr == 1) PG8_BAR;
        PG8_WAIT_V(2); PG8_BAR;
        PG8_STAGE(PG8_SB(1, 0), cB + kstep, voffB); PG8_STAGE(PG8_SA(1, 0), cA + kstep, voffA); PG8_STAGE(PG8_SB(1, 1), cB + hstep + kstep, voffB);
        PG8_WAIT_V(6); PG8_BAR;
    } else {
        PG8_STAGE(PG8_SB(0, 0), cB, voffB); PG8_STAGE(PG8_SA(0, 0), cA, voffA); PG8_STAGE(PG8_SB(0, 1), cB + hstep, voffB); PG8_STAGE(PG8_SA(0, 1), cA + hstep, voffA);
        if (wr == 1) PG8_BAR;
        PG8_WAIT_V(4); PG8_BAR;
        PG8_STAGE(PG8_SB(1, 0), cB + kstep, voffB); PG8_STAGE(PG8_SA(1, 0), cA + kstep, voffA); PG8_STAGE(PG8_SB(1, 1), cB + hstep + kstep, voffB);
        PG8_WAIT_V(6); PG8_BAR;
    }
    for (;;) {
        const bool has_next = S.next(ui + 1, nxt);
        const char* nA = has_next ? (const char*)g.A + (size_t)nxt.pm * tstep : cA; const char* nB = has_next ? (const char*)g.Bt + (size_t)nxt.pn * tstep : cB;
        for (int t = 0; t < nt; t += 2) {
            const bool last = (t == nt - 2);
            const char* a1 = cA + (size_t)(t + 1) * kstep;
            const char* a2 = last ? nA : cA + (size_t)(t + 2) * kstep; const char* b2 = last ? nB : cB + (size_t)(t + 2) * kstep;
            const char* a3 = a2 + kstep; const char* b3 = b2 + kstep;
            if (last && has_next) S.a_ready(nxt);
            if constexpr (SP2) {
            PG8_LDB(B0, 0, 0); PG8_LDB(B1, 0, 1); PG8_SCHED; PG8_LDA(At, 0, 0); PG8_STAGE(PG8_SA(1, 1), a1 + hstep, voffA);
            PG8_WAIT_V(8); PG8_WAIT_L(0); PG8_BAR; PG8_MMA(0, 0, At, B0); PG8_MMA(0, 1, At, B1); PG8_BAR; PG8_SCHED;
            PG8_LDA(At, 0, 1); PG8_STAGE(PG8_SB(0, 0), b2, voffB); PG8_STAGE(PG8_SB(0, 1), b2 + hstep, voffB); PG8_STAGE(PG8_SA(0, 0), a2, voffA);
            PG8_WAIT_V(8); PG8_WAIT_L(0); PG8_BAR; PG8_MMA(1, 0, At, B0); PG8_MMA(1, 1, At, B1); PG8_BAR; PG8_SCHED;
            PG8_LDB(B0, 1, 0); PG8_LDB(B1, 1, 1); PG8_SCHED; PG8_LDA(At, 1, 0); PG8_STAGE(PG8_SA(0, 1), a2 + hstep, voffA);
            PG8_WAIT_V(8); PG8_WAIT_L(0); PG8_BAR; PG8_MMA(0, 0, At, B0); PG8_MMA(0, 1, At, B1); PG8_BAR; PG8_SCHED;
            PG8_LDA(At, 1, 1); PG8_STAGE(PG8_SB(1, 0), b3, voffB); PG8_STAGE(PG8_SB(1, 1), b3 + hstep, voffB); PG8_STAGE(PG8_SA(1, 0), a3, voffA);
            PG8_WAIT_V(8); PG8_WAIT_L(0); PG8_BAR; PG8_MMA(1, 0, At, B0); PG8_MMA(1, 1, At, B1); PG8_BAR; PG8_SCHED;
            } else {
            PG8_LDB(B0, 0, 0); PG8_SCHED; PG8_LDA(At, 0, 0); PG8_STAGE(PG8_SA(1, 1), a1 + hstep, voffA);
            PG8_WAIT_L(8); PG8_BAR; PG8_WAIT_L(0); PG8_MMA(0, 0, At, B0); PG8_BAR; PG8_SCHED;
            PG8_LDB(B1, 0, 1); PG8_STAGE(PG8_SB(0, 0), b2, voffB);
            PG8_BAR; PG8_WAIT_L(0); PG8_MMA(0, 1, At, B1); PG8_BAR;
            PG8_LDA(At, 0, 1); PG8_STAGE(PG8_SA(0, 0), a2, voffA);
            PG8_BAR; PG8_WAIT_L(0); PG8_MMA(1, 0, At, B0); PG8_BAR; PG8_SCHED;
            PG8_STAGE(PG8_SB(0, 1), b2 + hstep, voffB);
            PG8_WAIT_V(6); PG8_BAR; PG8_MMA(1, 1, At, B1); PG8_BAR;
            PG8_LDB(B0, 1, 0); PG8_SCHED; PG8_LDA(At, 1, 0); PG8_STAGE(PG8_SA(0, 1), a2 + hstep, voffA);
            PG8_WAIT_L(8); PG8_BAR; PG8_WAIT_L(0); PG8_MMA(0, 0, At, B0); PG8_BAR; PG8_SCHED;
            PG8_LDB(B1, 1, 1); PG8_STAGE(PG8_SB(1, 0), b3, voffB);
            PG8_BAR; PG8_WAIT_L(0); PG8_MMA(0, 1, At, B1); PG8_BAR;
            PG8_LDA(At, 1, 1); PG8_STAGE(PG8_SA(1, 0), a3, voffA);
            PG8_BAR; PG8_WAIT_L(0); PG8_MMA(1, 0, At, B0); PG8_BAR; PG8_SCHED;
            PG8_STAGE(PG8_SB(1, 1), b3 + hstep, voffB);
            PG8_WAIT_V(6); PG8_BAR; PG8_MMA(1, 1, At, B1); PG8_BAR;
            }
        }
        if constexpr (ALIGN_EPI) { if (wr == 0) PG8_BAR; }
        if constexpr (!Epi::AFTER_DRAIN) { E(acc, cur, wr, wc, fr, fq); S.done(cur); }
        if (!has_next) break;
#pragma unroll
        for (int a = 0; a < 2; ++a)
#pragma unroll
            for (int b = 0; b < 2; ++b)
#pragma unroll
                for (int m = 0; m < 4; ++m)
#pragma unroll
                    for (int n = 0; n < 2; ++n) acc[a][b][m][n] = (f32x4){0.f, 0.f, 0.f, 0.f};
        cur = nxt; cA = nA; cB = nB; ++ui;
        if constexpr (ALIGN_EPI) { if (wr == 1) PG8_BAR; }
    }
    PG8_WAIT_V(0);
    if constexpr (!ALIGN_EPI) { if (wr == 0) PG8_BAR; }
    PG8_BAR;
    if constexpr (Epi::AFTER_DRAIN) { E.fused(acc, cur, wr, wc, fr, fq, lds, wid, lane); S.done(cur); }
#undef PG8_SA
#undef PG8_SB
#undef PG8_STAGE
#undef PG8_LDA
#undef PG8_LDB
#undef PG8_MMA
#undef PG8_WAIT_V
#undef PG8_WAIT_L
#undef PG8_BAR
#undef PG8_SCHED
}
}

#ifndef PG8_SP2
#define PG8_SP2 true
#endif
#ifndef PG8_ALIGN
#define PG8_ALIGN true
#endif
namespace attn_body {
using bf16=__hip_bfloat16;
using bf16x8=__attribute__((ext_vector_type(8)))short;
using s16x4=__attribute__((ext_vector_type(4)))short;
using f32x16=__attribute__((ext_vector_type(16)))float;
using u32x4=__attribute__((ext_vector_type(4)))unsigned;
constexpr int BATCH=16,NHEAD=16,SEQ=4096,D=64,DM=NHEAD*D;
constexpr int NW=8,QBLK=32,QB=QBLK*NW,KVBLK=64,NQB=SEQ/QB;
constexpr int ATTN_PITCH=DM, ATTN_UNIT_ROWS=QB;
__device__ __forceinline__ int crow(int r,int hi){return (r&3)+8*(r>>2)+4*hi;}
#define SBAR() __builtin_amdgcn_sched_barrier(0)
__device__ __forceinline__ void cmask(f32x16&p0,f32x16&p1,int jb,int qrel,int hi){
  const float NEG=-INFINITY; int kb=64*jb+4*hi;
  #pragma unroll
  for(int r=0;r<16;++r){int kv=kb+(r&3)+8*(r>>2); if(kv>qrel)p0[r]=NEG; if(kv+32>qrel)p1[r]=NEG;}
}

constexpr int NSLOT=3, SLOTB=8192;
constexpr int LDS_K=0, LDS_V=NSLOT*SLOTB, LDS_WS=2*NSLOT*SLOTB, LDS_OST=LDS_WS+NW*64*4, LDS_STASH=LDS_OST+NW*4096, LDS_BYTES=LDS_STASH+NW*8192;
constexpr float C2=0.125f*1.4426950408889634f;
__device__ __forceinline__ void glds16(const void*gsrc,unsigned lds_dst){unsigned keep;
  asm volatile("s_mov_b32 %0, m0\n\ts_mov_b32 m0, %2\n\ts_nop 0\n\tglobal_load_lds_dwordx4 %1, off\n\ts_mov_b32 m0, %0":"=&s"(keep):"v"(gsrc),"s"(lds_dst):"memory");}
__device__ __forceinline__ float max3f(float a,float b,float c){float r;asm("v_max3_f32 %0, %1, %2, %3":"=v"(r):"v"(a),"v"(b),"v"(c));return r;}
__device__ __forceinline__ float max2f(float a,float b){float r;asm("v_max_f32_e32 %0, %1, %2":"=v"(r):"v"(a),"v"(b));return r;}
__device__ __forceinline__ float fadd_s(float a,float b){float r;asm("v_add_f32_e32 %0, %1, %2":"=v"(r):"v"(a),"v"(b));return r;}
__device__ __forceinline__ float fsub_s(float a,float b){float r;asm("v_sub_f32_e32 %0, %1, %2":"=v"(r):"v"(a),"v"(b));return r;}
typedef float f32x2_t __attribute__((ext_vector_type(2))); typedef __bf16 bf16x2_t __attribute__((ext_vector_type(2)));
__device__ __forceinline__ unsigned cvtpk_s(float lo,float hi){f32x2_t v={lo,hi};bf16x2_t b=__builtin_convertvector(v,bf16x2_t);return __builtin_bit_cast(unsigned,b);}
#define WAIT_BAR(N) asm volatile("s_waitcnt vmcnt(" #N ") lgkmcnt(0)\n\ts_barrier":::"memory")

__device__ __forceinline__ void qkt(f32x16&p0,f32x16&p1,const char*Kslot,const bf16x8*qr,const f32x16&negm,int r32,int hi){
  const char*kb=Kslot+hi*1024+r32*16;
  #pragma unroll
  for(int d0=0;d0<4;++d0){
    const bf16x8 b0=*reinterpret_cast<const bf16x8*>(kb+d0*2048);
    const bf16x8 b1=*reinterpret_cast<const bf16x8*>(kb+d0*2048+512);
    if(d0==0){p0=__builtin_amdgcn_mfma_f32_32x32x16_bf16(b0,qr[0],negm,0,0,0);p1=__builtin_amdgcn_mfma_f32_32x32x16_bf16(b1,qr[0],negm,0,0,0);}
    else{p0=__builtin_amdgcn_mfma_f32_32x32x16_bf16(b0,qr[d0],p0,0,0,0);p1=__builtin_amdgcn_mfma_f32_32x32x16_bf16(b1,qr[d0],p1,0,0,0);}}
}
typedef __attribute__((address_space(3))) const char* lds_cptr;
typedef short v4i16_t __attribute__((ext_vector_type(4)));
__device__ __forceinline__ void kload8(bf16x8*kf,lds_cptr kp){
  kf[0]=*(const __attribute__((address_space(3))) bf16x8*)(kp);      kf[1]=*(const __attribute__((address_space(3))) bf16x8*)(kp+512);
  kf[2]=*(const __attribute__((address_space(3))) bf16x8*)(kp+2048); kf[3]=*(const __attribute__((address_space(3))) bf16x8*)(kp+2560);
  kf[4]=*(const __attribute__((address_space(3))) bf16x8*)(kp+4096); kf[5]=*(const __attribute__((address_space(3))) bf16x8*)(kp+4608);
  kf[6]=*(const __attribute__((address_space(3))) bf16x8*)(kp+6144); kf[7]=*(const __attribute__((address_space(3))) bf16x8*)(kp+6656);
}
__device__ __forceinline__ void kload2(bf16x8*kf,lds_cptr kp,int j){ kf[2*j]=*(const __attribute__((address_space(3))) bf16x8*)(kp+j*2048); kf[2*j+1]=*(const __attribute__((address_space(3))) bf16x8*)(kp+j*2048+512); }
__device__ __forceinline__ s16x4 vtr(lds_cptr p){ return __builtin_bit_cast(s16x4,__builtin_amdgcn_ds_read_tr16_b64_v4i16((__attribute__((address_space(3))) v4i16_t*)p)); }
__device__ __forceinline__ float rowmax(const f32x16&p0,const f32x16&p1){
  float a=max3f(p0[0],p0[1],p1[0]),b=max3f(p0[2],p0[3],p1[1]);a=max3f(a,p1[2],p1[3]);
  #pragma unroll
  for(int r=4;r<16;r+=4){a=max3f(a,p0[r],p0[r+1]);b=max3f(b,p0[r+2],p0[r+3]);a=max3f(a,p1[r],p1[r+1]);b=max3f(b,p1[r+2],p1[r+3]);}
  const float m=max2f(a,b);
  auto rr=__builtin_amdgcn_permlane32_swap(__float_as_uint(m),__float_as_uint(m),false,false);
  return max2f(__uint_as_float(rr[0]),__uint_as_float(rr[1]));
}
__device__ __forceinline__ void pv(f32x16*o,int vb,bf16x8 pa0,bf16x8 pa1,bf16x8 pa2,bf16x8 pa3){
  #pragma unroll
  for(int d0=0;d0<2;++d0){s16x4 lo[4],hi[4];
    #pragma unroll
    for(int ks=0;ks<4;++ks){
      asm volatile("ds_read_b64_tr_b16 %0,%1 offset:%c2":"=&v"(lo[ks]):"v"(vb),"i"(d0*4096+ks*1024):"memory");
      asm volatile("ds_read_b64_tr_b16 %0,%1 offset:%c2":"=&v"(hi[ks]):"v"(vb),"i"(d0*4096+ks*1024+512):"memory");}
    asm volatile("s_waitcnt lgkmcnt(0)":::"memory");SBAR();
    #define PK(k) (bf16x8){lo[k][0],lo[k][1],lo[k][2],lo[k][3],hi[k][0],hi[k][1],hi[k][2],hi[k][3]}
    o[d0]=__builtin_amdgcn_mfma_f32_32x32x16_bf16(pa0,PK(0),o[d0],0,0,0);
    o[d0]=__builtin_amdgcn_mfma_f32_32x32x16_bf16(pa1,PK(1),o[d0],0,0,0);
    o[d0]=__builtin_amdgcn_mfma_f32_32x32x16_bf16(pa2,PK(2),o[d0],0,0,0);
    o[d0]=__builtin_amdgcn_mfma_f32_32x32x16_bf16(pa3,PK(3),o[d0],0,0,0);
    #undef PK
  }
}

#ifndef ATTN_STORE16
#define ATTN_STORE16(p,v) (*(u32x4*)(p)=(v))
#endif
template<int THRL> __device__ __forceinline__ void attn_unit(int b,int h,int hv,int qb,const bf16*Q,const bf16*__restrict__ K,const bf16*__restrict__ V,bf16*O,char*shm,int mode,float lam){
  int tid_=threadIdx.x; asm volatile("":"+v"(tid_)); const int tid=tid_,lane=tid&63,r32=lane&31,hi=lane>>5; const int wid=__builtin_amdgcn_readfirstlane(tid>>6);
  const long rowbase=(long)b*SEQ; const int q0=qb*QB;
  const bf16*Qw=Q+(rowbase+q0+wid*QBLK)*DM+h*D;
  const bf16*Kh=K+rowbase*DM+h*D,*Vh=V+rowbase*DM+hv*D;
  const unsigned lds0=(unsigned)(uintptr_t)shm;
  float*wsf=(float*)(shm+LDS_WS)+wid*64;
  const bf16*ksrc=Kh+(long)lane*DM+wid*8;
  const bf16*vsrc=Vh+(long)(16*(wid&3)+(lane>>2))*DM+(wid>>2)*32+(lane&3)*8;
  const unsigned kdst=lds0+LDS_K+wid*1024, vdst=lds0+LDS_V+wid*1024;
  #define DMA_K(t,slot) glds16(ksrc+(long)(t)*KVBLK*DM,(unsigned)__builtin_amdgcn_readfirstlane(kdst+(slot)))
  #define DMA_V(t,slot) glds16(vsrc+(long)(t)*KVBLK*DM,(unsigned)__builtin_amdgcn_readfirstlane(vdst+(slot)))
  const int vb0=(int)(lds0+LDS_V)+((lane>>4)&1)*32+(lane&3)*8+(4*hi+((lane&15)>>2))*64;
  const char*Kbase=shm+LDS_K; bf16x8 kf[8];
  const lds_cptr shm3=(lds_cptr)shm; const lds_cptr kp0=shm3+LDS_K+hi*1024+r32*16; const lds_cptr vp0=shm3+LDS_V+((lane>>4)&1)*32+(lane&3)*8+(4*hi+((lane&15)>>2))*64;
  const int NT=(q0+QB)/KVBLK;
  DMA_K(0,0);DMA_V(0,0);DMA_K(1,SLOTB);
  bf16x8 qr[4];
  #pragma unroll
  for(int d0=0;d0<4;++d0)qr[d0]=*reinterpret_cast<const bf16x8*>(&Qw[(long)r32*DM+d0*16+hi*8]);
  float mhat=0.f,l_reg=0.f;f32x16 o[2];o[0]=f32x16{};o[1]=f32x16{};f32x16 negm=f32x16{};asm volatile("":"+v"(negm));
  const int qrel=wid*QBLK+r32;
  #define CMASK(P0,P1,t) do{int jb_=(t)-(NT-4); if(jb_>=0)cmask(P0,P1,jb_,qrel,hi);}while(0)
  bool resc=false;
  #define START(P0,P1) do{ const float rm=rowmax(P0,P1); resc=false; \
    { const float dl=rm; mhat=fadd_s(mhat,dl); \
      _Pragma("unroll") for(int r=0;r<16;++r){P0[r]=fsub_s(P0[r],dl);P1[r]=fsub_s(P1[r],dl);} \
      _Pragma("unroll") for(int r=0;r<16;++r)negm[r]=-mhat; asm volatile("":"+v"(negm)); } \
    _Pragma("unroll") for(int r=0;r<16;++r)P0[r]=__builtin_amdgcn_exp2f(P0[r]); }while(0)
  #define RESC() do{ if(resc){ asm volatile("s_waitcnt lgkmcnt(0)":::"memory"); \
      _Pragma("unroll") for(int d_=0;d_<2;++d_) _Pragma("unroll") for(int r=0;r<16;++r)o[d_][r]*=wsf[crow(r,hi)]; } }while(0)
  f32x16 pA0,pA1,pB0,pB1;
  int sl_prev=0,sl_cur=0,sl_next=SLOTB;
  #define ROT() do{sl_prev=sl_cur;sl_cur=sl_next;sl_next=(sl_next==(NSLOT-1)*SLOTB)?0:sl_next+SLOTB;}while(0)
  DMA_K(2,2*SLOTB);
  WAIT_BAR(3);
  qkt(pA0,pA1,Kbase,qr,negm,r32,hi);asm volatile("s_nop 15\n\ts_nop 7":"+v"(pA0),"+v"(pA1));CMASK(pA0,pA1,0);
  START(pA0,pA1);
  _Pragma("unroll") for(int r=0;r<16;++r)pA1[r]=__builtin_amdgcn_exp2f(pA1[r]);
  WAIT_BAR(0);
  DMA_K(3,0);DMA_V(1,SLOTB);
  ROT();
  kload8(kf,kp0+sl_cur);
  WAIT_BAR(2);
  s16x4 vlo[8],vhi[8]; u32x4 pw0,pw1,pw2,pw3;
  #define PKW(P,B) cvtpk_s(P[B],P[B+1])
  #define PAF(k) __builtin_bit_cast(bf16x8,pw##k)
  #define VFR(i) (bf16x8){vlo[i][0],vlo[i][1],vlo[i][2],vlo[i][3],vhi[i][0],vhi[i][1],vhi[i][2],vhi[i][3]}
  #define PIN(x) asm volatile("":"+v"(x))
  #define MX3(a,b,c) __builtin_fmaxf(__builtin_fmaxf((a),(b)),(c))
  #define GAPA(MF,A0,A1,A2,A3,W0,W1,PW) do{ MF; sacc+=A0; sacc+=A1; sacc+=A2; sacc+=A3; PIN(sacc); W0; W1; PIN(PW); SBAR(); }while(0)
  #define EX(v) __builtin_amdgcn_exp2f(v)
  #define GAPB(MF,X,B) do{ MF; X[B]=EX(X[B]); X[B+1]=EX(X[B+1]); X[B+2]=EX(X[B+2]); X[B+3]=EX(X[B+3]); PIN(X); SBAR(); }while(0)
  #define VRD(i) do{ vlo[i]=vtr(vp_+(((i)>>2)*4096+((i)&3)*1024)); vhi[i]=vtr(vp_+(((i)>>2)*4096+((i)&3)*1024+512)); }while(0)
  #define KRD(G,j) do{ if(G){ kload2(kf,kp0+sl_next,j); SBAR(); } }while(0)
  #define STEP(C0,C1,P0,P1,t,GK,GV,GL) do{ SBAR(); \
    const lds_cptr vp_=vp0+sl_prev; \
    VRD(0); SBAR(); float sacc=(P0[0]+P0[1]); \
    GAPA(C0=__builtin_amdgcn_mfma_f32_32x32x16_bf16(kf[0],qr[0],negm,0,0,0), P0[2],P0[3],P0[4],P0[5],     pw0[0]=PKW(P0,0), pw0[1]=PKW(P0,2), pw0); \
    VRD(4); SBAR(); GAPA(C1=__builtin_amdgcn_mfma_f32_32x32x16_bf16(kf[1],qr[0],negm,0,0,0), P0[6],P0[7],P0[8],P0[9],     pw0[2]=PKW(P0,4), pw0[3]=PKW(P0,6), pw0); \
    VRD(1); SBAR(); GAPA(C0=__builtin_amdgcn_mfma_f32_32x32x16_bf16(kf[2],qr[1],C0,0,0,0),   P0[10],P0[11],P0[12],P0[13], pw1[0]=PKW(P0,8), pw1[1]=PKW(P0,10), pw1); \
    VRD(5); SBAR(); GAPA(C1=__builtin_amdgcn_mfma_f32_32x32x16_bf16(kf[3],qr[1],C1,0,0,0),   P0[14],P0[15],P1[0],P1[1],   pw1[2]=PKW(P0,12),pw1[3]=PKW(P0,14), pw1); \
    VRD(2); SBAR(); GAPA(C0=__builtin_amdgcn_mfma_f32_32x32x16_bf16(kf[4],qr[2],C0,0,0,0),   P1[2],P1[3],P1[4],P1[5],     pw2[0]=PKW(P1,0), pw2[1]=PKW(P1,2), pw2); \
    VRD(6); SBAR(); GAPA(C1=__builtin_amdgcn_mfma_f32_32x32x16_bf16(kf[5],qr[2],C1,0,0,0),   P1[6],P1[7],P1[8],P1[9],     pw2[2]=PKW(P1,4), pw2[3]=PKW(P1,6), pw2); \
    VRD(3); SBAR(); GAPA(C0=__builtin_amdgcn_mfma_f32_32x32x16_bf16(kf[6],qr[3],C0,0,0,0),   P1[10],P1[11],P1[12],P1[13], pw3[0]=PKW(P1,8), pw3[1]=PKW(P1,10), pw3); \
    VRD(7); SBAR(); GAPA(C1=__builtin_amdgcn_mfma_f32_32x32x16_bf16(kf[7],qr[3],C1,0,0,0),   P1[14],P1[15],0.f,0.f,       pw3[2]=PKW(P1,12),pw3[3]=PKW(P1,14), pw3); \
    l_reg+=sacc; \
    if(GK){DMA_K((t)+3,sl_cur);} if(GV){DMA_V((t)+1,sl_next);} \
    CMASK(C0,C1,t); \
    { float a=MX3(C0[0],C0[1],C1[0]),b=MX3(C0[2],C0[3],C1[1]); a=MX3(a,C1[2],C1[3]); \
      _Pragma("unroll") for(int r=4;r<16;r+=4){a=MX3(a,C0[r],C0[r+1]);b=MX3(b,C0[r+2],C0[r+3]);a=MX3(a,C1[r],C1[r+1]);b=MX3(b,C1[r+2],C1[r+3]);} \
      float rm=__builtin_fmaxf(a,b); { auto rr=__builtin_amdgcn_permlane32_swap(__float_as_uint(rm),__float_as_uint(rm),false,false); rm=__builtin_fmaxf(__uint_as_float(rr[0]),__uint_as_float(rr[1])); } \
      resc=false; \
      if(__builtin_expect(__any(rm>(float)THRL),0)){ const float dl=__builtin_fmaxf(rm,0.f); mhat+=dl; \
        _Pragma("unroll") for(int r=0;r<16;++r){C0[r]-=dl;C1[r]-=dl;} \
        _Pragma("unroll") for(int r=0;r<16;++r)negm[r]=-mhat; asm volatile("":"+v"(negm)); \
        const float f=__builtin_amdgcn_exp2f(-dl); l_reg*=f; if(hi==0)wsf[r32]=f; resc=true; } } \
    SBAR(); \
    GAPB(o[0]=__builtin_amdgcn_mfma_f32_32x32x16_bf16(PAF(0),VFR(0),o[0],0,0,0), C0,0); \
    GAPB(o[1]=__builtin_amdgcn_mfma_f32_32x32x16_bf16(PAF(0),VFR(4),o[1],0,0,0), C0,4); \
    KRD(GL,0); GAPB(o[0]=__builtin_amdgcn_mfma_f32_32x32x16_bf16(PAF(1),VFR(1),o[0],0,0,0), C0,8); \
    KRD(GL,1); GAPB(o[1]=__builtin_amdgcn_mfma_f32_32x32x16_bf16(PAF(1),VFR(5),o[1],0,0,0), C0,12); \
    KRD(GL,2); GAPB(o[0]=__builtin_amdgcn_mfma_f32_32x32x16_bf16(PAF(2),VFR(2),o[0],0,0,0), C1,0); \
    KRD(GL,3); GAPB(o[1]=__builtin_amdgcn_mfma_f32_32x32x16_bf16(PAF(2),VFR(6),o[1],0,0,0), C1,4); \
    GAPB(o[0]=__builtin_amdgcn_mfma_f32_32x32x16_bf16(PAF(3),VFR(3),o[0],0,0,0), C1,8); \
    GAPB(o[1]=__builtin_amdgcn_mfma_f32_32x32x16_bf16(PAF(3),VFR(7),o[1],0,0,0), C1,12); \
    }while(0)
  int t=1;
  #undef CMASK
  #define CMASK(P0,P1,t) do{}while(0)
  for(;t+5<NT;t+=2){
    STEP(pB0,pB1,pA0,pA1,t,true,true,true);     WAIT_BAR(2); RESC(); ROT();
    STEP(pA0,pA1,pB0,pB1,t+1,true,true,true);   WAIT_BAR(2); RESC(); ROT();
  }
  #undef CMASK
  #define CMASK(P0,P1,t) do{int jb_=(t)-(NT-4); if(jb_>=0)cmask(P0,P1,jb_,qrel,hi);}while(0)
  #define ENDW(tt) do{ if((tt)+3<NT){WAIT_BAR(2);} else if((tt)+2<NT){WAIT_BAR(1);} else {WAIT_BAR(0);} }while(0)
  for(;t+1<NT;t+=2){
    STEP(pB0,pB1,pA0,pA1,t,(t+3<NT),(t+1<NT),(t+1<NT));       ENDW(t);   RESC(); ROT();
    STEP(pA0,pA1,pB0,pB1,t+1,(t+4<NT),(t+2<NT),(t+2<NT));     ENDW(t+1); RESC(); ROT();
  }
  STEP(pB0,pB1,pA0,pA1,NT-1,false,false,false); RESC();
  { float sacc=pB0[0]+pB0[1]; _Pragma("unroll") for(int r=2;r<16;++r)sacc+=pB0[r]; _Pragma("unroll") for(int r=0;r<16;++r)sacc+=pB1[r]; l_reg+=sacc;
    pw0=(u32x4){PKW(pB0,0),PKW(pB0,2),PKW(pB0,4),PKW(pB0,6)};pw1=(u32x4){PKW(pB0,8),PKW(pB0,10),PKW(pB0,12),PKW(pB0,14)};pw2=(u32x4){PKW(pB1,0),PKW(pB1,2),PKW(pB1,4),PKW(pB1,6)};pw3=(u32x4){PKW(pB1,8),PKW(pB1,10),PKW(pB1,12),PKW(pB1,14)};
    SBAR(); pv(o,vb0+sl_cur,PAF(0),PAF(1),PAF(2),PAF(3)); }
  #undef PKW
  #undef PAF
  #undef VFR
  #undef PIN
  #undef MX3
  #undef GAPA
  #undef GAPB
  #undef EX
  #undef VRD
  #undef KRD
  #undef STEP
  #undef ENDW
  {auto rr=__builtin_amdgcn_permlane32_swap(__float_as_uint(l_reg),__float_as_uint(l_reg),false,false);l_reg=__uint_as_float(rr[0])+__uint_as_float(rr[1]);}
  if(hi==0)wsf[32+r32]=l_reg;asm volatile("s_waitcnt lgkmcnt(0)":::"memory");
  float rli[16];
  #pragma unroll
  for(int r=0;r<16;++r)rli[r]=__builtin_amdgcn_rcpf(wsf[32+crow(r,hi)]);
  bf16*Ow=O+(rowbase+q0+wid*QBLK)*DM+hv*D;
  float*stash=(float*)(shm+LDS_STASH)+wid*2048;
  if(mode==0){
    #pragma unroll
    for(int r=0;r<16;++r){
      #pragma unroll
      for(int d0=0;d0<2;++d0)stash[(d0*16+r)*64+lane]=o[d0][r]*rli[r];}
    asm volatile("s_waitcnt lgkmcnt(0)":::"memory");
  } else { bf16*stg=(bf16*)(shm+LDS_OST)+wid*2048;
    #pragma unroll
    for(int r=0;r<16;++r){const int orow=crow(r,hi);
      #pragma unroll
      for(int d0=0;d0<2;++d0)stg[orow*64+d0*32+r32]=__float2bfloat16(stash[(d0*16+r)*64+lane]-lam*(o[d0][r]*rli[r]));}
    asm volatile("s_waitcnt lgkmcnt(0)":::"memory");
    #pragma unroll
    for(int i=0;i<4;++i){const int row=i*8+(lane>>3),ch=lane&7; const u32x4 v=*(const u32x4*)(stg+row*64+ch*8); ATTN_STORE16(Ow+(long)row*DM+ch*8,v);} }
  asm volatile("s_waitcnt lgkmcnt(0)\n\ts_barrier":::"memory");
  #undef DMA_K
  #undef DMA_V
  #undef CMASK
  #undef START
  #undef RESC
  #undef ROT
}
constexpr int ATTN_LDS_BYTES=LDS_BYTES;
struct AttnTensors { const bf16* Q; const bf16* K; const bf16* V; bf16* O; };
template<int THRL=8> __device__ __forceinline__ void attn_phase(char*lds,const AttnTensors&T,int vcu,int G,float lam){
  for(int ubase=vcu*32; ubase<BATCH*8*2*32; ubase+=G*32)
  for(int i=0;i<32;++i){ const int uu=ubase+i, s2=uu>>5, j=(uu>>1)&15, sub=uu&1; const int qb=(j&1)?(NQB-1-(j>>1)):(j>>1);
      attn_unit<THRL>(s2>>4,((s2>>1)&7)*2+sub,(s2&15),qb,T.Q,T.K,T.V,T.O,lds,sub,lam); }
}
#undef SBAR
#undef WAIT_BAR
}

#define LAS __attribute__((address_space(3)))
typedef unsigned short bf16;
typedef unsigned v4u __attribute__((ext_vector_type(4)));
typedef unsigned v2u __attribute__((ext_vector_type(2)));
typedef float f32x4 __attribute__((ext_vector_type(4)));
typedef float f32x2v __attribute__((ext_vector_type(2)));
typedef short bf16x8 __attribute__((ext_vector_type(8)));
constexpr int NWAVES = 8, NTHR = 512;
constexpr int BATCH = 16, SEQ = 4096, D = 1024, M = BATCH * SEQ, FF = 4096;
constexpr int N1 = 8448;
constexpr float EPS = 1e-6f;
constexpr size_t MiB = 1u << 20;
constexpr size_t WS_W1 = 1 * MiB, WS_WA = 18 * MiB, WS_WB = 20 * MiB, WS_WO = 22 * MiB, WS_WUP = 24 * MiB, WS_WDN = 32 * MiB;
constexpr size_t WS_ROPE = 40 * MiB, WS_GLOW = 44 * MiB;
constexpr size_t WS_U = 48 * MiB;
constexpr size_t WS_GQ = 176 * MiB, WS_GK = 240 * MiB, WS_GV = 304 * MiB, WS_SOG = 432 * MiB, WS_DQ = 560 * MiB, WS_DK = 688 * MiB, WS_DV = 816 * MiB, WS_END = 944 * MiB;
constexpr size_t WS_T = WS_DQ, WS_MIXIN = WS_DK, WS_MIXED = WS_GQ, WS_HMID = WS_SOG, WS_F = WS_GQ;
constexpr int LDS_BYTES = 155648;

__device__ __forceinline__ unsigned f2bf(float f) { unsigned u = __builtin_bit_cast(unsigned, f); return (u + 0x7fffu + ((u >> 16) & 1u)) >> 16; }
typedef __bf16 bf16x2_hw __attribute__((ext_vector_type(2)));
__device__ __forceinline__ unsigned pk2(float lo, float hi) { f32x2v v = {lo, hi}; bf16x2_hw b = __builtin_convertvector(v, bf16x2_hw); return __builtin_bit_cast(unsigned, b); }
__device__ __forceinline__ float bflo(unsigned w) { return __uint_as_float(w << 16); }
__device__ __forceinline__ float bfhi(unsigned w) { return __uint_as_float(w & 0xffff0000u); }
__device__ __forceinline__ float wave_sum(float v) {
#pragma unroll
    for (int o = 1; o < 64; o <<= 1) v += __shfl_xor(v, o);
    return v;
}

__device__ __forceinline__ int w1_src_col(int n) { return n < 3072 ? n : (n < 8192 ? n + 16 : (n < 8208 ? n - 8192 + 3072 : -1)); }
template <bool REMAP> __device__ __forceinline__ void p0_transpose_item(const float* W, int K, int N, int NT, bf16* WT, LAS float* scr, int item, int lane) {
    const int nblk = NT / 32, kb = item / nblk, nb = item % nblk, k0 = 64 * kb, n0 = 32 * nb;
    const int sc = REMAP ? w1_src_col(n0 + (lane & 31)) : n0 + (lane & 31);
#pragma unroll 8
    for (int i = 0; i < 32; ++i) { const int kk = 2 * i + (lane >> 5); scr[kk * 33 + (lane & 31)] = sc >= 0 ? W[(size_t)(k0 + kk) * N + sc] : 0.f; }
    asm volatile("s_waitcnt lgkmcnt(0)" ::: "memory");
    const int c = lane & 7;
#pragma unroll
    for (int j = 0; j < 4; ++j) { const int n = (lane >> 3) + 8 * j; const LAS float* s = scr + (8 * c) * 33 + n;
        v4u o; o.x = pk2(s[0 * 33], s[1 * 33]); o.y = pk2(s[2 * 33], s[3 * 33]); o.z = pk2(s[4 * 33], s[5 * 33]); o.w = pk2(s[6 * 33], s[7 * 33]);
        *(v4u*)(WT + (size_t)(n0 + n) * K + k0 + 8 * c) = o; }
    asm volatile("s_waitcnt lgkmcnt(0)" ::: "memory");
}

struct Args { const float* in[21]; float* out; unsigned char* ws; };

__device__ __forceinline__ void p0_prologue(const Args& a, LAS unsigned char* lds, int gw, int NGW, int wave, int lane) {
    LAS float* scr = (LAS float*)(lds + wave * 16384);
    unsigned char* ws = a.ws;
    constexpr int I_1 = (D / 64) * (N1 / 32), I_S = (D / 64) * (D / 32), I_UP = (D / 64) * (FF / 32), I_DN = (FF / 64) * (D / 32);
    constexpr int NITEMS = I_1 + 3 * I_S + I_UP + I_DN;
    for (int it = gw; it < NITEMS; it += NGW) {
        int r = it;
        if (r < I_1) { p0_transpose_item<true>(a.in[2], D, 8208, N1, (bf16*)(ws + WS_W1), scr, r, lane); continue; } r -= I_1;
        if (r < I_S) { p0_transpose_item<false>(a.in[12], D, D, D, (bf16*)(ws + WS_WA), scr, r, lane); continue; } r -= I_S;
        if (r < I_S) { p0_transpose_item<false>(a.in[13], D, D, D, (bf16*)(ws + WS_WB), scr, r, lane); continue; } r -= I_S;
        if (r < I_S) { p0_transpose_item<false>(a.in[14], D, D, D, (bf16*)(ws + WS_WO), scr, r, lane); continue; } r -= I_S;
        if (r < I_UP) { p0_transpose_item<false>(a.in[19], D, FF, FF, (bf16*)(ws + WS_WUP), scr, r, lane); continue; } r -= I_UP;
        p0_transpose_item<false>(a.in[20], FF, D, D, (bf16*)(ws + WS_WDN), scr, r, lane);
    }
    { const int* pos = (const int*)a.in[1]; float* rope = (float*)(ws + WS_ROPE);
      for (int e = gw * 64 + lane; e < M * 8; e += NGW * 64) { const int m = e >> 3, i = e & 7;
          const float inv = exp2f(-(float)i * 0.125f * 18.931568569324174f);
          const double rev = (double)pos[m] * (double)inv * 0.15915494309189535;
          const float fr = (float)(rev - rint(rev));
          rope[(size_t)m * 16 + i] = __builtin_amdgcn_cosf(fr); rope[(size_t)m * 16 + 8 + i] = __builtin_amdgcn_sinf(fr); } }
    { const float* x = a.in[0]; const float* w = a.in[15]; bf16* U = (bf16*)(ws + WS_U);
      f32x4 wv[4];
#pragma unroll
      for (int j = 0; j < 4; ++j) wv[j] = ((const f32x4*)w)[64 * j + lane];
      for (int m = gw; m < M; m += NGW) { const f32x4* xr = (const f32x4*)(x + (size_t)m * D) + lane; f32x4 v[4]; float s = 0.f;
#pragma unroll
          for (int j = 0; j < 4; ++j) { v[j] = xr[64 * j]; s += (v[j].x * v[j].x + v[j].y * v[j].y) + (v[j].z * v[j].z + v[j].w * v[j].w); }
          const float rstd = rsqrtf(wave_sum(s) * (1.f / D) + EPS);
          unsigned long long* o8 = (unsigned long long*)(U + (size_t)m * D) + lane;
#pragma unroll
          for (int j = 0; j < 4; ++j) { const f32x4 t = v[j] * rstd * wv[j]; o8[64 * j] = (unsigned long long)pk2(t.x, t.y) | ((unsigned long long)pk2(t.z, t.w) << 32); } } }
}

namespace gla {
constexpr int C = 64, DK = 128, DVS = 64, NCH = SEQ / C;
constexpr int PQ = 136, PJ = 72;
constexpr int O_QI = 0, O_KJ = O_QI + 64 * PQ * 2, O_QIN = O_KJ + 64 * PQ * 2, O_KST = O_QIN + 64 * PQ * 2, O_VT = O_KST + 128 * PJ * 2, O_AM = O_VT + 64 * PJ * 2,
              O_SB = O_AM + 64 * PJ * 2, O_GL = O_SB + 2 * 64 * PQ * 2, O_T = O_GL + 64 * 16 * 4, O_DEC = O_T + 2 * 10 * 128 * 4, O_END = O_DEC + 128 * 4;
static_assert(O_END <= LDS_BYTES, "gla LDS");
typedef float f32x4 __attribute__((ext_vector_type(4)));
__device__ __forceinline__ f32x4 mfma16(bf16x8 a, bf16x8 b, f32x4 c) { return __builtin_amdgcn_mfma_f32_16x16x32_bf16(a, b, c, 0, 0, 0); }
__device__ __forceinline__ bf16x8 ld8(const LAS unsigned char* p) { return *(const LAS bf16x8*)p; }
__device__ __forceinline__ float logsig(float z) { return fminf(z, 0.f) - __logf(1.0f + __expf(-fabsf(z))); }

__device__ __forceinline__ void item(const Args& a, LAS unsigned char* lds, int b, int h, int vs, int tid, bf16* OUT) {
    const int wave = __builtin_amdgcn_readfirstlane(tid >> 6), lane = tid & 63;
    unsigned char* ws = a.ws;
    const bf16* GQ = (const bf16*)(ws + WS_GQ); const bf16* GK = (const bf16*)(ws + WS_GK); const bf16* GV = (const bf16*)(ws + WS_GV); const float* GLOW = (const float*)(ws + WS_GLOW);
    const float* wup = a.in[4]; const float* bgk = a.in[5];
    const int d0 = 2 * lane;
    f32x2v wu[16];
#pragma unroll
    for (int r = 0; r < 16; ++r) wu[r] = *(const f32x2v*)(wup + r * 512 + h * 128 + d0);
    const f32x2v bg = *(const f32x2v*)(bgk + h * 128 + d0);
    const size_t row0 = (size_t)b * SEQ;
    for (int e = tid; e < 64 * PQ / 2; e += NTHR) ((LAS unsigned*)(lds + O_SB))[e] = 0u;
    f32x4 S[4];
#pragma unroll
    for (int t = 0; t < 4; ++t) S[t] = (f32x4){0.f, 0.f, 0.f, 0.f};
    unsigned pq[8], pk[8]; unsigned short pv[8]; f32x4 pgl = {0.f, 0.f, 0.f, 0.f};
    auto prefetch = [&](int n) {
        const size_t r0 = row0 + (size_t)n * C + 8 * wave;
#pragma unroll
        for (int i = 0; i < 8; ++i) { pq[i] = *(const unsigned*)(GQ + (r0 + i) * 512 + h * 128 + d0); pk[i] = *(const unsigned*)(GK + (r0 + i) * 512 + h * 128 + d0);
            pv[i] = GV[(r0 + i) * 1024 + h * 256 + vs * 64 + lane]; }
        if (tid < 256) pgl = *(const f32x4*)(GLOW + (row0 + (size_t)n * C) * 16 + tid * 4);
    };
    prefetch(0);
    if (tid < 256) *(LAS f32x4*)(lds + O_GL + tid * 16) = pgl;
    __syncthreads();
    const float qs = 0.08838834764831845f;
    for (int n = 0; n < NCH; ++n) {
        float g0[8], g1[8];
#pragma unroll
        for (int i = 0; i < 8; ++i) { const LAS f32x4* gp = (const LAS f32x4*)(lds + O_GL + (8 * wave + i) * 64); f32x2v z = bg;
#pragma unroll
            for (int r4 = 0; r4 < 4; ++r4) { const f32x4 gl = gp[r4];
#pragma unroll
                for (int j = 0; j < 4; ++j) z = z + wu[4 * r4 + j] * gl[j]; }
            g0[i] = logsig(z.x) * 0.0625f; g1[i] = logsig(z.y) * 0.0625f; }
        const float first0 = g0[0], first1 = g1[0];
#pragma unroll
        for (int i = 1; i < 8; ++i) { g0[i] += g0[i - 1]; g1[i] += g1[i - 1]; }
        LAS float* T = (LAS float*)(lds + O_T + (n & 1) * 10 * 128 * 4);
        *(LAS f32x2v*)(T + wave * 128 + d0) = (f32x2v){g0[7], g1[7]};
        if (wave == 4) *(LAS f32x2v*)(T + 8 * 128 + d0) = (f32x2v){first0, first1};
        unsigned cq[8], ck[8]; unsigned short cv[8];
#pragma unroll
        for (int i = 0; i < 8; ++i) { cq[i] = pq[i]; ck[i] = pk[i]; cv[i] = pv[i]; }
        __syncthreads();
        if (n + 1 < NCH) prefetch(n + 1);
        float pre0 = 0.f, pre1 = 0.f, mid0 = 0.f, mid1 = 0.f, tot0 = 0.f, tot1 = 0.f;
#pragma unroll
        for (int w = 0; w < 8; ++w) { const f32x2v t = *(const LAS f32x2v*)(T + w * 128 + d0); if (w < wave) { pre0 += t.x; pre1 += t.y; } if (w < 4) { mid0 += t.x; mid1 += t.y; } tot0 += t.x; tot1 += t.y; }
        { const f32x2v t = *(const LAS f32x2v*)(T + 8 * 128 + d0); mid0 += t.x; mid1 += t.y; }
        const float em0 = __expf(-mid0), em1 = __expf(-mid1), ep0 = __expf(mid0), ep1 = __expf(mid1), el0 = __expf(tot0), el1 = __expf(tot1);
        if (wave == 0) *(LAS f32x2v*)(lds + O_DEC + d0 * 4) = (f32x2v){el0, el1};
        unsigned kst0[4], kst1[4];
        const f32x2v em = {em0, em1}, ep = {ep0, ep1}, el = {el0, el1}, pre = {pre0, pre1};
#pragma unroll
        for (int i2 = 0; i2 < 4; ++i2) { f32x2v ks[2];
#pragma unroll
            for (int ii = 0; ii < 2; ++ii) { const int i = 2 * i2 + ii;
                const f32x2v Gv = pre + (f32x2v){g0[i], g1[i]};
                f32x2v E, R; E.x = __expf(Gv.x); E.y = __expf(Gv.y); R.x = __builtin_amdgcn_rcpf(E.x); R.y = __builtin_amdgcn_rcpf(E.y);
                const f32x2v q = (f32x2v){bflo(cq[i]), bfhi(cq[i])} * qs, k = {bflo(ck[i]), bfhi(ck[i])};
                const f32x2v qe = q * E, kr = k * R, qi = qe * em, kj = kr * ep; ks[ii] = kr * el;
                const int row = 8 * wave + i;
                *(LAS unsigned*)(lds + O_QIN + (row * PQ + d0) * 2) = pk2(qe.x, qe.y);
                *(LAS unsigned*)(lds + O_QI + (row * PQ + d0) * 2) = pk2(qi.x, qi.y);
                *(LAS unsigned*)(lds + O_KJ + (row * PQ + d0) * 2) = pk2(kj.x, kj.y); }
            kst0[i2] = pk2(ks[0].x, ks[1].x); kst1[i2] = pk2(ks[0].y, ks[1].y); }
        *(LAS v4u*)(lds + O_KST + (d0 * PJ + 8 * wave) * 2) = (v4u){kst0[0], kst0[1], kst0[2], kst0[3]};
        *(LAS v4u*)(lds + O_KST + ((d0 + 1) * PJ + 8 * wave) * 2) = (v4u){kst1[0], kst1[1], kst1[2], kst1[3]};
        { v4u vv; vv.x = cv[0] | ((unsigned)cv[1] << 16); vv.y = cv[2] | ((unsigned)cv[3] << 16); vv.z = cv[4] | ((unsigned)cv[5] << 16); vv.w = cv[6] | ((unsigned)cv[7] << 16);
          *(LAS v4u*)(lds + O_VT + (lane * PJ + 8 * wave) * 2) = vv; }
        __syncthreads();
        if (n + 1 < NCH && tid < 256) *(LAS f32x4*)(lds + O_GL + tid * 16) = pgl;
        const int fr = lane & 15, fq = lane >> 4;
        { const int it = wave >> 1;
#pragma unroll
          for (int jj = 0; jj < 2; ++jj) { const int jt = 2 * (wave & 1) + jj; f32x4 acc = {0.f, 0.f, 0.f, 0.f};
#pragma unroll
              for (int ks = 0; ks < 4; ++ks) acc = mfma16(ld8(lds + O_KJ + ((16 * jt + fr) * PQ + ks * 32 + fq * 8) * 2), ld8(lds + O_QI + ((16 * it + fr) * PQ + ks * 32 + fq * 8) * 2), acc);
              const int i = 16 * it + fr, j0 = 16 * jt + 4 * fq;
#pragma unroll
              for (int e = 0; e < 4; ++e) if (j0 + e > i) acc[e] = 0.f;
              *(LAS v2u*)(lds + O_AM + (i * PJ + j0) * 2) = (v2u){pk2(acc[0], acc[1]), pk2(acc[2], acc[3])}; } }
        __syncthreads();
        { const int ct = wave >> 1; const LAS unsigned char* SB = lds + O_SB + (n & 1) * 64 * PQ * 2;
#pragma unroll
          for (int ii = 0; ii < 2; ++ii) { const int it = 2 * (wave & 1) + ii; f32x4 acc = {0.f, 0.f, 0.f, 0.f};
#pragma unroll
              for (int ks = 0; ks < 2; ++ks) acc = mfma16(ld8(lds + O_VT + ((16 * ct + fr) * PJ + ks * 32 + fq * 8) * 2), ld8(lds + O_AM + ((16 * it + fr) * PJ + ks * 32 + fq * 8) * 2), acc);
#pragma unroll
              for (int ks = 0; ks < 4; ++ks) acc = mfma16(ld8(SB + ((16 * ct + fr) * PQ + ks * 32 + fq * 8) * 2), ld8(lds + O_QIN + ((16 * it + fr) * PQ + ks * 32 + fq * 8) * 2), acc);
              const size_t grow = row0 + (size_t)n * C + 16 * it + fr;
              *(v2u*)(OUT + grow * 1024 + h * 256 + vs * 64 + 16 * ct + 4 * fq) = (v2u){pk2(acc[0], acc[1]), pk2(acc[2], acc[3])}; } }
        { const f32x4 dec = *(const LAS f32x4*)(lds + O_DEC + (16 * wave + 4 * fq) * 4); LAS unsigned char* SBn = lds + O_SB + ((n + 1) & 1) * 64 * PQ * 2;
          const bf16x8 ka0 = ld8(lds + O_KST + ((16 * wave + fr) * PJ + fq * 8) * 2), ka1 = ld8(lds + O_KST + ((16 * wave + fr) * PJ + 32 + fq * 8) * 2);
#pragma unroll
          for (int ct = 0; ct < 4; ++ct) { f32x4 s = S[ct] * dec;
              s = mfma16(ka0, ld8(lds + O_VT + ((16 * ct + fr) * PJ + fq * 8) * 2), s);
              s = mfma16(ka1, ld8(lds + O_VT + ((16 * ct + fr) * PJ + 32 + fq * 8) * 2), s);
              S[ct] = s;
              *(LAS v2u*)(SBn + ((16 * ct + fr) * PQ + 16 * wave + 4 * fq) * 2) = (v2u){pk2(s[0], s[1]), pk2(s[2], s[3])}; } }
    }
    __syncthreads();
}
}

__device__ __forceinline__ void p3_norms(const Args& a, int gw, int NGW, int lane) {
    unsigned char* ws = a.ws; bf16* OA = (bf16*)(ws + WS_GV); const bf16* SOG = (const bf16*)(ws + WS_SOG); bf16* OB = (bf16*)(ws + WS_U);
    const float* wa = a.in[6]; const float* wb = a.in[11];
    float wav[16], wbv[16];
#pragma unroll
    for (int j = 0; j < 16; ++j) { wav[j] = wa[(16 * lane + j) & 255]; wbv[j] = wb[(16 * lane + j) & 127] * 0.8f; }
    for (int m = gw; m < M; m += NGW) {
        { v4u* p = (v4u*)(OA + (size_t)m * D + 16 * lane); const v4u* g = (const v4u*)(SOG + (size_t)m * D + 16 * lane);
          const v4u x0 = p[0], x1 = p[1], g0 = g[0], g1 = g[1]; float v[16], gg[16];
          const unsigned xs[8] = {x0.x, x0.y, x0.z, x0.w, x1.x, x1.y, x1.z, x1.w}, gs[8] = {g0.x, g0.y, g0.z, g0.w, g1.x, g1.y, g1.z, g1.w};
          float s = 0.f;
#pragma unroll
          for (int j = 0; j < 8; ++j) { v[2 * j] = bflo(xs[j]); v[2 * j + 1] = bfhi(xs[j]); gg[2 * j] = bflo(gs[j]); gg[2 * j + 1] = bfhi(gs[j]); s += v[2 * j] * v[2 * j] + v[2 * j + 1] * v[2 * j + 1]; }
          s += __shfl_xor(s, 1); s += __shfl_xor(s, 2); s += __shfl_xor(s, 4); s += __shfl_xor(s, 8);
          const float rstd = rsqrtf(s * (1.f / 256.f) + EPS); unsigned o[8];
#pragma unroll
          for (int j = 0; j < 8; ++j) o[j] = pk2(v[2 * j] * rstd * wav[2 * j] * gg[2 * j], v[2 * j + 1] * rstd * wav[2 * j + 1] * gg[2 * j + 1]);
          p[0] = (v4u){o[0], o[1], o[2], o[3]}; p[1] = (v4u){o[4], o[5], o[6], o[7]}; }
        { v4u* p = (v4u*)(OB + (size_t)m * D + 16 * lane); const v4u x0 = p[0], x1 = p[1]; float v[16];
          const unsigned xs[8] = {x0.x, x0.y, x0.z, x0.w, x1.x, x1.y, x1.z, x1.w}; float s = 0.f;
#pragma unroll
          for (int j = 0; j < 8; ++j) { v[2 * j] = bflo(xs[j]); v[2 * j + 1] = bfhi(xs[j]); s += v[2 * j] * v[2 * j] + v[2 * j + 1] * v[2 * j + 1]; }
          s += __shfl_xor(s, 1); s += __shfl_xor(s, 2); s += __shfl_xor(s, 4);
          const float rstd = rsqrtf(s * (1.f / 128.f) + EPS); unsigned o[8];
#pragma unroll
          for (int j = 0; j < 8; ++j) o[j] = pk2(v[2 * j] * rstd * wbv[2 * j], v[2 * j + 1] * rstd * wbv[2 * j + 1]);
          p[0] = (v4u){o[0], o[1], o[2], o[3]}; p[1] = (v4u){o[4], o[5], o[6], o[7]}; }
    }
}
__device__ __forceinline__ void p5b_resid_norm(const Args& a, int gw, int NGW, int lane) {
    unsigned char* ws = a.ws; const float* MX = (const float*)(ws + WS_MIXED); bf16* H = (bf16*)(ws + WS_U);
    const float* x = a.in[0]; const float* w1 = a.in[16]; const float* w2 = a.in[17];
    for (int m = gw; m < M; m += NGW) { const f32x4* mr = (const f32x4*)(MX + (size_t)m * D) + lane; const f32x4* xr = (const f32x4*)(x + (size_t)m * D) + lane; f32x4* orow = (f32x4*)(a.out + (size_t)m * D) + lane;
        f32x4 v[4]; float s = 0.f;
#pragma unroll
        for (int j = 0; j < 4; ++j) { v[j] = mr[64 * j]; s += (v[j].x * v[j].x + v[j].y * v[j].y) + (v[j].z * v[j].z + v[j].w * v[j].w); }
        const float rstd = rsqrtf(wave_sum(s) * (1.f / D) + EPS); float s2 = 0.f;
#pragma unroll
        for (int j = 0; j < 4; ++j) { v[j] = xr[64 * j] + v[j] * rstd * ((const f32x4*)w1)[64 * j + lane]; orow[64 * j] = v[j]; s2 += (v[j].x * v[j].x + v[j].y * v[j].y) + (v[j].z * v[j].z + v[j].w * v[j].w); }
        const float rstd2 = rsqrtf(wave_sum(s2) * (1.f / D) + EPS);
        unsigned long long* o8 = (unsigned long long*)(H + (size_t)m * D) + lane;
#pragma unroll
        for (int j = 0; j < 4; ++j) { const f32x4 t = v[j] * rstd2 * ((const f32x4*)w2)[64 * j + lane]; o8[64 * j] = (unsigned long long)pk2(t.x, t.y) | ((unsigned long long)pk2(t.z, t.w) << 32); } }
}
__device__ __forceinline__ void p7b_final(const Args& a, int gw, int NGW, int lane) {
    const float* F = (const float*)(a.ws + WS_F); const float* w = a.in[18];
    for (int m = gw; m < M; m += NGW) { const f32x4* fr = (const f32x4*)(F + (size_t)m * D) + lane; f32x4* orow = (f32x4*)(a.out + (size_t)m * D) + lane;
        f32x4 v[4]; float s = 0.f;
#pragma unroll
        for (int j = 0; j < 4; ++j) { v[j] = fr[64 * j]; s += (v[j].x * v[j].x + v[j].y * v[j].y) + (v[j].z * v[j].z + v[j].w * v[j].w); }
        const float rstd = rsqrtf(wave_sum(s) * (1.f / D) + EPS);
#pragma unroll
        for (int j = 0; j < 4; ++j) orow[64 * j] = orow[64 * j] + v[j] * rstd * ((const f32x4*)w)[64 * j + lane]; }
}

__global__ void __launch_bounds__(NTHR, 2) fwd_megakernel(Args args) {
    extern __shared__ __attribute__((aligned(16))) unsigned char lds_raw[];
    cg::grid_group grid = cg::this_grid();
#ifdef PROBE_SYNC2
#define GSYNC() do { grid.sync(); grid.sync(); } while (0)
#else
#define GSYNC() grid.sync()
#endif
    LAS unsigned char* lds = (LAS unsigned char*)lds_raw;
#define FRESH_TID() int tid = threadIdx.x; asm volatile("" : "+v"(tid)); const int lane = tid & 63, wave = __builtin_amdgcn_readfirstlane(tid >> 6); const int gw = vcu * NWAVES + wave; (void)lane; (void)gw
    const int G = gridDim.x, bx = blockIdx.x; const int vcu = (G % 8 == 0) ? (bx % 8) * (G / 8) + bx / 8 : bx;
    const int NGW = G * NWAVES;
    unsigned char* ws = args.ws;
    bf16* W1t = (bf16*)(ws + WS_W1); bf16* U = (bf16*)(ws + WS_U);
    bf16* GATES = (bf16*)args.out;

    { FRESH_TID(); p0_prologue(args, lds, gw, NGW, wave, lane); }
#ifdef PROBE_P0
    { FRESH_TID(); p0_prologue(args, lds, gw, NGW, wave, lane); }
#endif
    GSYNC();
#ifndef NO_P1
    { pg8::Gemm g{U, W1t, M, N1, D}; pg8::StaticOrder S; S.init(M, N1, G, bx);
      pg8::EpiP1 E{(bf16*)(ws + WS_GQ), (bf16*)(ws + WS_GK), (bf16*)(ws + WS_GV), (bf16*)(ws + WS_SOG), (bf16*)(ws + WS_DQ), (bf16*)(ws + WS_DK), (bf16*)(ws + WS_DV), GATES,
                   (float*)(ws + WS_GLOW), (const float*)(ws + WS_ROPE), args.in[3], attn_body::C2};
      pg8::gemm_phase<pg8::EpiP1, pg8::StaticOrder, PG8_ALIGN, PG8_SP2>(lds, g, S, E);
#ifdef PROBE_P12
      __syncthreads(); pg8::gemm_phase<pg8::EpiP1, pg8::StaticOrder, PG8_ALIGN, PG8_SP2>(lds, g, S, E);
#endif
    }
#endif
    GSYNC();
#ifndef NO_GLA
#ifdef PROBE_GLA2
    { FRESH_TID(); for (int it = vcu; it < BATCH * 4 * 4; it += G) gla::item(args, lds, it >> 4, (it >> 2) & 3, it & 3, tid, (bf16*)(ws + WS_U)); }
    GSYNC();
#endif
    { FRESH_TID(); for (int it = vcu; it < BATCH * 4 * 4; it += G) gla::item(args, lds, it >> 4, (it >> 2) & 3, it & 3, tid, (bf16*)(ws + WS_GV)); }
#endif
#ifndef NO_ATTN
    { FRESH_TID(); float lam;
      { const float p1 = wave_sum(args.in[7][lane] * args.in[8][lane]), p2 = wave_sum(args.in[9][lane] * args.in[10][lane]); lam = __uint_as_float(__builtin_amdgcn_readfirstlane(__float_as_uint(expf(p1) - expf(p2) + 0.2f))); }
      const attn_body::AttnTensors AT{(const attn_body::bf16*)(ws + WS_DQ), (const attn_body::bf16*)(ws + WS_DK), (const attn_body::bf16*)(ws + WS_DV), (attn_body::bf16*)(ws + WS_U)};
      attn_body::attn_phase<8>((char*)lds_raw, AT, vcu, G, lam);
#ifdef PROBE_ATTN2
      attn_body::attn_phase<8>((char*)lds_raw, AT, vcu, G, lam);
#endif
    }
#endif
    GSYNC();
    { FRESH_TID(); p3_norms(args, gw, NGW, lane); }
    GSYNC();
#ifndef NO_REST
#ifdef PROBE_P42
    for (int rep_ = 0; rep_ < 2; ++rep_)
#endif
    { pg8::StaticOrder S; S.init(M, D, G, bx);
      { pg8::Gemm g{(bf16*)(ws + WS_GV), (bf16*)(ws + WS_WA), M, D, D}; pg8::EpiN<0> E{(bf16*)(ws + WS_T), nullptr, D, GATES, 0, nullptr};
        pg8::gemm_phase<pg8::EpiN<0>, pg8::StaticOrder, PG8_ALIGN, PG8_SP2>(lds, g, S, E); }
      __syncthreads();
      { pg8::Gemm g{(bf16*)(ws + WS_U), (bf16*)(ws + WS_WB), M, D, D}; pg8::EpiN<1> E{(bf16*)(ws + WS_MIXIN), nullptr, D, GATES, 1024, (const bf16*)(ws + WS_T)};
        pg8::gemm_phase<pg8::EpiN<1>, pg8::StaticOrder, PG8_ALIGN, PG8_SP2>(lds, g, S, E); }
      __syncthreads(); }
    GSYNC();
    { pg8::Gemm g{(bf16*)(ws + WS_MIXIN), (bf16*)(ws + WS_WO), M, D, D}; pg8::StaticOrder S; S.init(M, D, G, bx); pg8::EpiN<2> E{nullptr, (float*)(ws + WS_MIXED), D, nullptr, 0, nullptr};
      pg8::gemm_phase<pg8::EpiN<2>, pg8::StaticOrder, PG8_ALIGN, PG8_SP2>(lds, g, S, E); }
    GSYNC();
    { FRESH_TID(); p5b_resid_norm(args, gw, NGW, lane); }
#ifdef PROBE_P5B
    { FRESH_TID(); p5b_resid_norm(args, gw, NGW, lane); }
#endif
    GSYNC();
    { pg8::Gemm g{(bf16*)(ws + WS_U), (bf16*)(ws + WS_WUP), M, FF, D}; pg8::StaticOrder S; S.init(M, FF, G, bx); pg8::EpiN<3> E{(bf16*)(ws + WS_HMID), nullptr, FF, nullptr, 0, nullptr};
      pg8::gemm_phase<pg8::EpiN<3>, pg8::StaticOrder, PG8_ALIGN, PG8_SP2>(lds, g, S, E);
#ifdef PROBE_P62
      __syncthreads(); pg8::gemm_phase<pg8::EpiN<3>, pg8::StaticOrder, PG8_ALIGN, PG8_SP2>(lds, g, S, E);
#endif
    }
    GSYNC();
    { pg8::Gemm g{(bf16*)(ws + WS_HMID), (bf16*)(ws + WS_WDN), M, D, FF}; pg8::StaticOrder S; S.init(M, D, G, bx); pg8::EpiN<2> E{nullptr, (float*)(ws + WS_F), D, nullptr, 0, nullptr};
      pg8::gemm_phase<pg8::EpiN<2>, pg8::StaticOrder, PG8_ALIGN, PG8_SP2>(lds, g, S, E);
#ifdef PROBE_P72
      __syncthreads(); pg8::gemm_phase<pg8::EpiN<2>, pg8::StaticOrder, PG8_ALIGN, PG8_SP2>(lds, g, S, E);
#endif
    }
    GSYNC();
    { FRESH_TID(); p7b_final(args, gw, NGW, lane); }
#endif
}

extern "C" void kernel_launch(void* const* d_in, const int* in_sizes, int n_in, void* d_out, int out_size, void* d_ws, size_t ws_size, hipStream_t stream) {
    static int grid = 0;
    if (grid == 0) {
        if (n_in != 21 || in_sizes[0] != M * D || out_size != M * D || ws_size < WS_END) { fprintf(stderr, "kernel_launch: unexpected shapes (n_in %d, in0 %d, out %d, ws %zu)\n", n_in, n_in > 0 ? in_sizes[0] : -1, out_size, ws_size); grid = -1; return; }
        int dev = 0, cus = 0, per_cu = 0;
        hipGetDevice(&dev); hipDeviceGetAttribute(&cus, hipDeviceAttributeMultiprocessorCount, dev);
        if (hipFuncSetAttribute((const void*)fwd_megakernel, hipFuncAttributeMaxDynamicSharedMemorySize, LDS_BYTES) != hipSuccess) { fprintf(stderr, "kernel_launch: hipFuncSetAttribute failed\n"); grid = -1; return; }
        if (hipOccupancyMaxActiveBlocksPerMultiprocessor(&per_cu, (const void*)fwd_megakernel, NTHR, LDS_BYTES) != hipSuccess || per_cu < 1) { fprintf(stderr, "kernel_launch: occupancy query says %d\n", per_cu); per_cu = 1; }
        (void)hipGetLastError();
        grid = cus * per_cu;
    }
    if (grid < 0) return;
    Args a{};
    for (int i = 0; i < 21; ++i) a.in[i] = (const float*)d_in[i];
    a.out = (float*)d_out; a.ws = (unsigned char*)d_ws;
    void* kargs[] = {&a};
    hipError_t e = hipLaunchCooperativeKernel((const void*)fwd_megakernel, dim3(grid), dim3(NTHR), kargs, LDS_BYTES, stream);
    if (e != hipSuccess) fprintf(stderr, "cooperative launch failed: %s (grid %d)\n", hipGetErrorString(e), grid);
}
```
